# Optimizing an MI355X kernel written in HIP

```python
import math
import jax, jax.numpy as jnp
from jax import lax
import numpy as np

D_MODEL = 1024
BATCH = 8
SEQ = 2048
DEPTH = 2
DEC_BATCH = 128
DEC_SEQ = 8
PAST_LEN = 16384
PAGE_SIZE = 128

EPS = 1e-6
GROUP_W = D_MODEL // 4
D_MIX = 4 * GROUP_W
SSM_HEADS = 4
SSM_HEAD_DIM = GROUP_W // SSM_HEADS
SSM_GROUPS = 2
SSM_STATE = 64
SSM_CONV = 4
SSM_CHUNK = 64
SSM_XBC = GROUP_W + 2 * SSM_GROUPS * SSM_STATE
WINDOW = 128
SWA_HEADS = 4
SWA_KV_HEADS = 2
SWA_HEAD_DIM = GROUP_W // SWA_HEADS
SWA_GROUP = SWA_HEADS // SWA_KV_HEADS
SWA_BLOCK = 128
N_BUCKETS = 32
MAX_DISTANCE = 128
HG_HEADS = 4
HG_DK = GROUP_W // HG_HEADS
HG_DV = GROUP_W // HG_HEADS
HG_CHUNK = 16
LRU_WIDTH = GROUP_W
LRU_BLOCKS = 4
LRU_BLOCK_W = LRU_WIDTH // LRU_BLOCKS
LRU_CONV = 4
LRU_C = 8.0
D_FF = 4 * D_MODEL

SPLIT_SIZES = [
    GROUP_W,
    SSM_XBC,
    SSM_HEADS,
    SWA_HEADS * SWA_HEAD_DIM,
    SWA_KV_HEADS * SWA_HEAD_DIM,
    SWA_KV_HEADS * SWA_HEAD_DIM,
    HG_HEADS * HG_DK,
    HG_HEADS * HG_DK,
    HG_HEADS * HG_DV,
    HG_HEADS * HG_DV,
    LRU_WIDTH,
    LRU_WIDTH,
]
N_IN = sum(SPLIT_SIZES)
SPLIT_POINTS = [int(v) for v in np.cumsum(SPLIT_SIZES)[:-1]]

kernel_name = 'hybrid_hymba_ssd_swa_hgrn2_rglru_step'


def rmsnorm(x, w):
    xf = x.astype(jnp.float32)
    y = xf * lax.rsqrt(jnp.mean(xf * xf, axis=-1, keepdims=True) + EPS)
    return (y * w.astype(jnp.float32)).astype(x.dtype)


def causal_dwconv(x, buf, w, b):
    K = w.shape[0]
    L = x.shape[1]
    xc = jnp.concatenate([buf.astype(x.dtype), x], axis=1)
    y = b.astype(x.dtype)
    for k in range(K):
        y = y + xc[:, k:k + L] * w[k].astype(x.dtype)
    return y, xc[:, -(K - 1):]


def pad_time(x, pad):
    if pad == 0:
        return x
    widths = [(0, 0)] * x.ndim
    widths[1] = (0, pad)
    return jnp.pad(x, widths)


def ssd_chunked(x, dt, A, Bm, Cm, h0, chunk):
    b, L, H, P = x.shape
    N = Bm.shape[-1]
    T = min(chunk, L)
    pad = (-L) % T
    x, dt, Bm, Cm = pad_time(x, pad), pad_time(dt, pad), pad_time(Bm, pad), pad_time(Cm, pad)
    nc = (L + pad) // T
    xs = (x * dt[..., None]).reshape(b, nc, T, H, P)
    a = (dt * A).reshape(b, nc, T, H)
    Bc = Bm.reshape(b, nc, T, H, N)
    Cc = Cm.reshape(b, nc, T, H, N)
    acum = jnp.cumsum(a, axis=2)
    seg = acum[:, :, :, None, :] - acum[:, :, None, :, :]
    mask = jnp.tril(jnp.ones((T, T), dtype=bool))
    decay = jnp.exp(jnp.where(mask[:, :, None], seg, -jnp.inf))
    scores = jnp.einsum('bcthn,bcshn->bctsh', Cc, Bc) * decay
    y_diag = jnp.einsum('bctsh,bcshp->bcthp', scores, xs)
    decay_s = jnp.exp(acum[:, :, -1:, :] - acum)
    states = jnp.einsum('bcshn,bcsh,bcshp->bchpn', Bc, decay_s, xs)
    chunk_decay = jnp.exp(acum[:, :, -1, :])

    def step(S, inp):
        st, dec = inp
        return S * dec[:, :, None, None] + st, S

    S_fin, S_in = lax.scan(step, h0, (jnp.moveaxis(states, 1, 0), jnp.moveaxis(chunk_decay, 1, 0)))
    S_in = jnp.moveaxis(S_in, 0, 1)
    y_off = jnp.einsum('bcthn,bchpn,bcth->bcthp', Cc, S_in, jnp.exp(acum))
    y = (y_diag + y_off).reshape(b, nc * T, H, P)[:, :L]
    return y, S_fin


def ssd_mixer(z, xbc, dt_raw, conv_buf, h0, conv_w, conv_b, dt_bias, A_log, Dskip, norm_w):
    b, L, _ = z.shape
    xbc, new_buf = causal_dwconv(xbc, conv_buf, conv_w, conv_b)
    xbc = jax.nn.silu(xbc)
    xs, Bm, Cm = jnp.split(xbc, [GROUP_W, GROUP_W + SSM_GROUPS * SSM_STATE], axis=-1)
    xs = xs.reshape(b, L, SSM_HEADS, SSM_HEAD_DIM)
    rep = SSM_HEADS // SSM_GROUPS
    Bm = jnp.repeat(Bm.reshape(b, L, SSM_GROUPS, SSM_STATE), rep, axis=2)
    Cm = jnp.repeat(Cm.reshape(b, L, SSM_GROUPS, SSM_STATE), rep, axis=2)
    dt = jax.nn.softplus(dt_raw + dt_bias.astype(jnp.float32))
    A = -jnp.exp(A_log.astype(jnp.float32))
    y, S = ssd_chunked(xs, dt, A, Bm, Cm, h0.astype(jnp.float32), SSM_CHUNK)
    y = y + xs * Dskip.astype(jnp.float32)[:, None]
    y = rmsnorm(y.reshape(b, L, GROUP_W) * jax.nn.silu(z), norm_w)
    return y, S, new_buf


def t5_buckets(n):
    max_exact = N_BUCKETS // 2
    nf = np.maximum(n, 1).astype(np.float32)
    large = max_exact + (np.log(nf / max_exact) / math.log(MAX_DISTANCE / max_exact)
                         * (N_BUCKETS - max_exact)).astype(np.int32)
    large = np.minimum(large, N_BUCKETS - 1)
    return np.where(n < max_exact, n, large).astype(np.int32)


def swa_mixer(q, k, v, k_buf, v_buf, pos0, sinks, rel_bias):
    b, L = q.shape[:2]
    Bq = min(SWA_BLOCK, L)
    pad = (-L) % Bq
    Lp = L + pad
    nb = Lp // Bq
    S = Bq + WINDOW
    k_cat = jnp.concatenate([k_buf.astype(jnp.float32), k], axis=1)
    v_cat = jnp.concatenate([v_buf.astype(jnp.float32), v], axis=1)
    new_k = k_cat[:, -WINDOW:]
    new_v = v_cat[:, -WINDOW:]
    qp = pad_time(q, pad).reshape(b, nb, Bq, SWA_KV_HEADS, SWA_GROUP, SWA_HEAD_DIM)
    idx = np.arange(nb)[:, None] * Bq + np.arange(S)[None, :]
    kb = pad_time(k_cat, pad)[:, idx]
    vb = pad_time(v_cat, pad)[:, idx]
    logits = jnp.einsum('bntkgd,bnskd->bnkgts', qp, kb) * (SWA_HEAD_DIM ** -0.5)
    t = np.arange(Bq)
    s = np.arange(S)
    diff = t[:, None] - s[None, :] + WINDOW
    k_pos = pos0 - WINDOW + np.arange(nb)[:, None] * Bq + s[None, :]
    valid = ((diff >= 0) & (diff < WINDOW))[None] & (k_pos >= 0)[:, None, :]
    bias = rel_bias.astype(jnp.float32)[t5_buckets(np.clip(diff, 0, WINDOW - 1))]
    bias = jnp.transpose(bias, (2, 0, 1)).reshape(SWA_KV_HEADS, SWA_GROUP, Bq, S)
    logits = jnp.where(valid[None, :, None, None], logits + bias[None, None], -jnp.inf)
    sink = jnp.broadcast_to(sinks.astype(jnp.float32).reshape(SWA_KV_HEADS, SWA_GROUP)[None, None, :, :, None, None],
                            logits.shape[:-1] + (1,))
    p = jax.nn.softmax(jnp.concatenate([logits, sink], axis=-1), axis=-1)[..., :-1]
    o = jnp.einsum('bnkgts,bnskd->bntkgd', p, vb).reshape(b, Lp, SWA_HEADS * SWA_HEAD_DIM)[:, :L]
    return o, new_k, new_v


def hgrn_lower_bounds(logits):
    p = jax.nn.softmax(logits.astype(jnp.float32), axis=0)
    return jnp.maximum(jnp.cumsum(p, axis=0) - p[0:1], 0.0)


def gla_chunked(q, logf, kk, v, S0, chunk):
    b, L, H, K = q.shape
    V = v.shape[-1]
    T = min(chunk, L)
    pad = (-L) % T
    q, logf, kk, v = pad_time(q, pad), pad_time(logf, pad), pad_time(kk, pad), pad_time(v, pad)
    nc = (L + pad) // T
    q = q.reshape(b, nc, T, H, K)
    kk = kk.reshape(b, nc, T, H, K)
    v = v.reshape(b, nc, T, H, V)
    bc = jnp.cumsum(logf.reshape(b, nc, T, H, K), axis=2)
    mask = jnp.tril(jnp.ones((T, T), dtype=bool))
    diff = bc[:, :, :, None] - bc[:, :, None, :]
    D = jnp.exp(jnp.where(mask[:, :, None, None], diff, -jnp.inf))
    A = jnp.einsum('bcthk,bctshk,bcshk->bchts', q, D, kk)
    o_intra = jnp.einsum('bchts,bcshv->bcthv', A, v)
    blast = bc[:, :, -1]
    kdec = kk * jnp.exp(blast[:, :, None] - bc)
    U = jnp.einsum('bcshk,bcshv->bchkv', kdec, v)
    dec = jnp.exp(blast)

    def step(S, inp):
        u, d = inp
        return S * d[..., None] + u, S

    S_fin, S_in = lax.scan(step, S0, (jnp.moveaxis(U, 1, 0), jnp.moveaxis(dec, 1, 0)))
    S_in = jnp.moveaxis(S_in, 0, 1)
    o_inter = jnp.einsum('bcthk,bchkv->bcthv', q * jnp.exp(bc), S_in)
    o = (o_intra + o_inter).reshape(b, nc * T, H, V)[:, :L]
    return o, S_fin


def hgrn2_mixer(q, f_raw, v, g, S0, lb, norm_w):
    b, L = q.shape[:2]
    lb = lb.reshape(HG_HEADS, HG_DK)
    logf = jnp.logaddexp(jnp.log(lb), jnp.log1p(-lb) + jax.nn.log_sigmoid(f_raw))
    kk = (1.0 - lb) * jax.nn.sigmoid(-f_raw)
    o, S = gla_chunked(q, logf, kk, v, S0.astype(jnp.float32), HG_CHUNK)
    o = rmsnorm(o, norm_w.reshape(HG_HEADS, HG_DV)) * jax.nn.sigmoid(g)
    return o.reshape(b, L, HG_HEADS * HG_DV), S


def _lin_combine(e1, e2):
    a1, b1 = e1
    a2, b2 = e2
    return a1 * a2, a2 * b1 + b2


def rglru_mixer(xb, gate, conv_buf, h0, conv_w, conv_b, wa, ba, wx, bx, lam):
    xc, new_buf = causal_dwconv(xb, conv_buf, conv_w, conv_b)
    b, L, _ = xc.shape
    xblk = xc.reshape(b, L, LRU_BLOCKS, LRU_BLOCK_W)
    r = jax.nn.sigmoid(jnp.einsum('blni,nij->blnj', xblk, wa).reshape(b, L, LRU_WIDTH) + ba)
    i = jax.nn.sigmoid(jnp.einsum('blni,nij->blnj', xblk, wx).reshape(b, L, LRU_WIDTH) + bx)
    log_a = -LRU_C * r * jax.nn.softplus(-lam.astype(jnp.float32))
    a = jnp.exp(log_a)
    u = jnp.sqrt(-jnp.expm1(2.0 * log_a)) * (i * xc)
    a_cum, u_cum = lax.associative_scan(_lin_combine, (a, u), axis=1)
    h = a_cum * h0.astype(jnp.float32)[:, None] + u_cum
    y = h * jax.nn.gelu(gate, approximate=True)
    return y, h[:, -1], new_buf


def layer(x, pos0, li, ck, cv, s_ssm, s_ssmc, s_hg, s_lru, s_lruc, P, lb):
    dtype = x.dtype
    b, L = x.shape[:2]
    h = rmsnorm(x, P['norm_mix_w'][li])
    proj = jnp.einsum('bld,de->ble', h, P['w_in'][li]).astype(jnp.float32)
    (z, xbc, dt_raw, q_a, k_a, v_a, q_h, f_h, i_h, g_h, x_r, g_r) = jnp.split(proj, SPLIT_POINTS, axis=-1)
    y_ssd, n_ssm, n_ssmc = ssd_mixer(z, xbc, dt_raw, s_ssmc, s_ssm, P['ssm_conv_w'][li], P['ssm_conv_b'][li],
                                     P['ssm_dt_bias'][li], P['ssm_A_log'][li], P['ssm_D'][li], P['ssm_norm_w'][li])
    y_swa, n_k, n_v = swa_mixer(q_a.reshape(b, L, SWA_HEADS, SWA_HEAD_DIM),
                                k_a.reshape(b, L, SWA_KV_HEADS, SWA_HEAD_DIM),
                                v_a.reshape(b, L, SWA_KV_HEADS, SWA_HEAD_DIM),
                                ck, cv, pos0, P['swa_sinks'][li], P['rel_bias'])
    y_hg, n_hg = hgrn2_mixer(q_h.reshape(b, L, HG_HEADS, HG_DK), f_h.reshape(b, L, HG_HEADS, HG_DK),
                             i_h.reshape(b, L, HG_HEADS, HG_DV), g_h.reshape(b, L, HG_HEADS, HG_DV),
                             s_hg, lb, P['hgrn_norm_w'][li])
    y_lru, n_lru, n_lruc = rglru_mixer(x_r, g_r, s_lruc, s_lru, P['lru_conv_w'][li], P['lru_conv_b'][li],
                                       P['lru_wa'][li], P['lru_ba'][li], P['lru_wx'][li], P['lru_bx'][li],
                                       P['lru_lambda'][li])
    mix = jnp.concatenate([y_ssd, y_swa, y_hg, y_lru], axis=-1).astype(dtype)
    x = x + jnp.einsum('ble,ed->bld', mix, P['w_out'][li])
    h2 = rmsnorm(x, P['norm_mlp_w'][li])
    up = jnp.einsum('bld,df->blf', h2, P['w_up'][li])
    x = x + jnp.einsum('blf,fd->bld', jnp.square(jax.nn.relu(up)), P['w_down'][li])
    return x, (n_k, n_v, n_ssm, n_ssmc, n_hg, n_lru, n_lruc)


def trunk(x, pos0, c_k, c_v, s_ssm, s_ssmc, s_hg, s_lru, s_lruc, P):
    lb_all = hgrn_lower_bounds(P['hgrn_lb_logits'])
    outs = [[] for _ in range(7)]
    for li in range(DEPTH):
        x, new = layer(x, pos0, li, c_k[li], c_v[li], s_ssm[li], s_ssmc[li], s_hg[li], s_lru[li], s_lruc[li], P, lb_all[li])
        for o, n in zip(outs, new):
            o.append(n.astype(x.dtype))
    y = rmsnorm(x, P['norm_f_w'])
    return y, [jnp.stack(o, axis=0) for o in outs]


def setup_inputs(seed: int = 0) -> dict:
    key = jax.random.key(seed)
    ks = iter(jax.random.split(key, 48))

    def nrm(shape, s):
        return jax.random.normal(next(ks), shape, jnp.float32) * s

    def unif(shape, lo, hi):
        return jax.random.uniform(next(ks), shape, jnp.float32, lo, hi)

    x_prompt = nrm((BATCH, SEQ, D_MODEL), 1.0)
    x_sample = nrm((DEC_BATCH, DEC_SEQ, D_MODEL), 1.0)
    cache_swa_k = nrm((DEPTH, DEC_BATCH, WINDOW, SWA_KV_HEADS, SWA_HEAD_DIM), 1.0)
    cache_swa_v = nrm((DEPTH, DEC_BATCH, WINDOW, SWA_KV_HEADS, SWA_HEAD_DIM), 1.0)
    state_ssm = nrm((DEPTH, DEC_BATCH, SSM_HEADS, SSM_HEAD_DIM, SSM_STATE), 0.5)
    state_ssm_conv = nrm((DEPTH, DEC_BATCH, SSM_CONV - 1, SSM_XBC), 1.0)
    state_hgrn = nrm((DEPTH, DEC_BATCH, HG_HEADS, HG_DK, HG_DV), 0.5)
    state_lru = nrm((DEPTH, DEC_BATCH, LRU_WIDTH), 0.5)
    state_lru_conv = nrm((DEPTH, DEC_BATCH, LRU_CONV - 1, LRU_WIDTH), 1.0)
    norm_mix_w = 1.0 + nrm((DEPTH, D_MODEL), 0.02)
    w_in = nrm((DEPTH, D_MODEL, N_IN), D_MODEL ** -0.5)
    ssm_conv_w = nrm((DEPTH, SSM_CONV, SSM_XBC), SSM_CONV ** -0.5)
    ssm_conv_b = nrm((DEPTH, SSM_XBC), 0.01)
    dt0 = jnp.exp(unif((DEPTH, SSM_HEADS), math.log(1e-3), math.log(1e-1)))
    ssm_dt_bias = dt0 + jnp.log(-jnp.expm1(-dt0))
    ssm_A_log = jnp.log(unif((DEPTH, SSM_HEADS), 1.0, 16.0))
    ssm_D = 1.0 + nrm((DEPTH, SSM_HEADS), 0.01)
    ssm_norm_w = 1.0 + nrm((DEPTH, GROUP_W), 0.02)
    swa_sinks = nrm((DEPTH, SWA_HEADS), 1.0)
    rel_bias = nrm((N_BUCKETS, SWA_HEADS), 0.5)
    hgrn_lb_logits = nrm((DEPTH, HG_HEADS * HG_DK), 1.0)
    hgrn_norm_w = 1.0 + nrm((DEPTH, HG_HEADS * HG_DV), 0.02)
    lru_conv_w = nrm((DEPTH, LRU_CONV, LRU_WIDTH), LRU_CONV ** -0.5)
    lru_conv_b = nrm((DEPTH, LRU_WIDTH), 0.01)
    lru_wa = nrm((DEPTH, LRU_BLOCKS, LRU_BLOCK_W, LRU_BLOCK_W), LRU_BLOCK_W ** -0.5)
    lru_ba = nrm((DEPTH, LRU_WIDTH), 0.01)
    lru_wx = nrm((DEPTH, LRU_BLOCKS, LRU_BLOCK_W, LRU_BLOCK_W), LRU_BLOCK_W ** -0.5)
    lru_bx = nrm((DEPTH, LRU_WIDTH), 0.01)
    sig = unif((DEPTH, LRU_WIDTH), 0.9, 0.999) ** (1.0 / LRU_C)
    lru_lambda = jnp.log(sig) - jnp.log1p(-sig)
    w_out = nrm((DEPTH, D_MIX, D_MODEL), D_MIX ** -0.5)
    norm_mlp_w = 1.0 + nrm((DEPTH, D_MODEL), 0.02)
    w_up = nrm((DEPTH, D_MODEL, D_FF), D_MODEL ** -0.5)
    w_down = nrm((DEPTH, D_FF, D_MODEL), D_FF ** -0.5)
    norm_f_w = 1.0 + nrm((D_MODEL,), 0.02)
    return {
        'x_prompt': x_prompt, 'x_sample': x_sample,
        'cache_swa_k': cache_swa_k, 'cache_swa_v': cache_swa_v,
        'state_ssm': state_ssm, 'state_ssm_conv': state_ssm_conv, 'state_hgrn': state_hgrn,
        'state_lru': state_lru, 'state_lru_conv': state_lru_conv,
        'norm_mix_w': norm_mix_w, 'w_in': w_in,
        'ssm_conv_w': ssm_conv_w, 'ssm_conv_b': ssm_conv_b, 'ssm_dt_bias': ssm_dt_bias,
        'ssm_A_log': ssm_A_log, 'ssm_D': ssm_D, 'ssm_norm_w': ssm_norm_w,
        'swa_sinks': swa_sinks, 'rel_bias': rel_bias,
        'hgrn_lb_logits': hgrn_lb_logits, 'hgrn_norm_w': hgrn_norm_w,
        'lru_conv_w': lru_conv_w, 'lru_conv_b': lru_conv_b, 'lru_wa': lru_wa, 'lru_ba': lru_ba,
        'lru_wx': lru_wx, 'lru_bx': lru_bx, 'lru_lambda': lru_lambda,
        'w_out': w_out, 'norm_mlp_w': norm_mlp_w, 'w_up': w_up, 'w_down': w_down, 'norm_f_w': norm_f_w,
    }


def reference(x_prompt, x_sample, cache_swa_k, cache_swa_v, state_ssm, state_ssm_conv, state_hgrn,
              state_lru, state_lru_conv, norm_mix_w, w_in, ssm_conv_w, ssm_conv_b, ssm_dt_bias, ssm_A_log,
              ssm_D, ssm_norm_w, swa_sinks, rel_bias, hgrn_lb_logits, hgrn_norm_w, lru_conv_w, lru_conv_b,
              lru_wa, lru_ba, lru_wx, lru_bx, lru_lambda, w_out, norm_mlp_w, w_up, w_down, norm_f_w):
    P = dict(norm_mix_w=norm_mix_w, w_in=w_in, ssm_conv_w=ssm_conv_w, ssm_conv_b=ssm_conv_b,
             ssm_dt_bias=ssm_dt_bias, ssm_A_log=ssm_A_log, ssm_D=ssm_D, ssm_norm_w=ssm_norm_w,
             swa_sinks=swa_sinks, rel_bias=rel_bias, hgrn_lb_logits=hgrn_lb_logits, hgrn_norm_w=hgrn_norm_w,
             lru_conv_w=lru_conv_w, lru_conv_b=lru_conv_b, lru_wa=lru_wa, lru_ba=lru_ba, lru_wx=lru_wx,
             lru_bx=lru_bx, lru_lambda=lru_lambda, w_out=w_out, norm_mlp_w=norm_mlp_w, w_up=w_up,
             w_down=w_down, norm_f_w=norm_f_w)
    f32 = jnp.float32
    z_k = jnp.zeros((DEPTH, BATCH, WINDOW, SWA_KV_HEADS, SWA_HEAD_DIM), f32)
    z_ssm = jnp.zeros((DEPTH, BATCH, SSM_HEADS, SSM_HEAD_DIM, SSM_STATE), f32)
    z_ssmc = jnp.zeros((DEPTH, BATCH, SSM_CONV - 1, SSM_XBC), f32)
    z_hg = jnp.zeros((DEPTH, BATCH, HG_HEADS, HG_DK, HG_DV), f32)
    z_lru = jnp.zeros((DEPTH, BATCH, LRU_WIDTH), f32)
    z_lruc = jnp.zeros((DEPTH, BATCH, LRU_CONV - 1, LRU_WIDTH), f32)
    y_prompt, st_p = trunk(x_prompt, 0, z_k, z_k, z_ssm, z_ssmc, z_hg, z_lru, z_lruc, P)
    p_k, p_v, p_ssm, p_ssmc, p_hg, p_lru, p_lruc = st_p
    y_sample, st_s = trunk(x_sample, PAST_LEN, cache_swa_k, cache_swa_v, state_ssm, state_ssm_conv,
                           state_hgrn, state_lru, state_lru_conv, P)
    s_k, s_v, s_ssm, s_ssmc, s_hg, s_lru, s_lruc = st_s
    return (y_prompt, y_sample, p_k, p_v, p_ssm, p_ssmc, p_hg, p_lru, p_lruc,
            s_k, s_v, s_ssm, s_ssmc, s_hg, s_lru, s_lruc)
```

```cpp
#include <hip/hip_runtime.h>
#include <cstdio>
#include <cstdint>
#include <cmath>
namespace pg8 {
#define PG8_LAS __attribute__((address_space(3)))
typedef unsigned short bf16_t;
typedef short bf16x8 __attribute__((ext_vector_type(8)));
typedef float f32x4 __attribute__((ext_vector_type(4)));
typedef unsigned u32x4 __attribute__((ext_vector_type(4)));
constexpr int BM = 256, BK = 64, HALF = 128, HTB = HALF * BK * 2  , STAGE_BYTES = 8 * HTB, NXCD = 8, WGM = 8;

__host__ __device__ __forceinline__ int lds_byte(int r, int c) { const int st = (r >> 4) * 2 + (c >> 5), rr = r & 15, cc = c & 31, ob = rr * 64 + cc * 2; return st * 1024 + (ob ^ (((ob >> 9) & 1) << 5)); }
__host__ __device__ __forceinline__ void stage_rc(int b, int& R, int& C) { const int st = b / 1024, sb = b % 1024, swz = sb ^ (((sb >> 9) & 1) << 5); R = (st >> 1) * 16 + swz / 64; C = (st & 1) * 32 + (swz % 64) / 2; }
__host__ __device__ __forceinline__ int perm32(int rho) { const int n = rho >> 4, i = rho & 15; return 8 * (i >> 2) + 4 * n + (i & 3); }

struct Unit { int pm, pn; };
struct Gemm { const bf16_t* A; const bf16_t* Bt; int M, N, K; };

struct StaticOrder {
    int nM, nN, nwg, G, c;
    __host__ __device__ void init(int M, int N, int G_, int c_) { nM = M / BM; nN = N / BM; nwg = nM * nN; G = G_; c = c_; }
    __host__ __device__ bool next(int i, Unit& u) const {
        const long L = (long)i * G + c; if (L >= nwg) return false;
        int wgid = (int)L; { const int q = nwg / NXCD, r = nwg % NXCD, xcd = wgid % NXCD, off = wgid / NXCD; wgid = (xcd < r ? xcd * (q + 1) : r * (q + 1) + (xcd - r) * q) + off; }
        const int nig = WGM * nN, gid = wgid / nig, fm = gid * WGM, gsz = (nM - fm) < WGM ? (nM - fm) : WGM;
        u.pm = fm + ((wgid % nig) % gsz); u.pn = (wgid % nig) / gsz; return true;
    }
    __device__ __forceinline__ void a_ready(const Unit&) const {}
    __device__ __forceinline__ void done(const Unit&) const {}
};
__device__ __forceinline__ unsigned cvt_pk_bf16(float lo, float hi) { unsigned r; asm volatile("v_cvt_pk_bf16_f32 %0, %1, %2" : "=v"(r) : "v"(lo), "v"(hi)); return r; }
typedef float f32x2 __attribute__((ext_vector_type(2)));
__device__ __forceinline__ float xsum4(const f32x4 v) { return (v[0] + v[1]) + (v[2] + v[3]); }
template <int ACT> struct EpiScaleBf16 {
    static constexpr bool PERM = true, AFTER_DRAIN = false;
    bf16_t* O; int ldc; const float* ssq;
    __device__ __forceinline__ void operator()(const f32x4 (&acc)[2][2][4][2], const Unit& u, int wr, int wc, int fr, int fq) const {
        const int row0 = u.pm * BM + wr * 64 + fr, col0 = u.pn * BM + wc * 32 + 8 * fq;
#pragma unroll
        for (int ai = 0; ai < 2; ++ai)
#pragma unroll
            for (int m = 0; m < 4; ++m) {
                const int row = row0 + ai * HALF + m * 16;
                const f32x4 pv = *(const f32x4*)(ssq + (size_t)row * 16 + 4 * fq);
                float s = xsum4(pv); s += __shfl_xor(s, 16); s += __shfl_xor(s, 32);
                const float rs = 1.0f / sqrtf(s * (1.0f / 1024.0f) + 1e-6f);
                bf16_t* rowp = O + (size_t)row * ldc + col0;
#pragma unroll
                for (int bj = 0; bj < 2; ++bj) {
                    f32x4 v0 = acc[ai][bj][m][0] * rs, v1 = acc[ai][bj][m][1] * rs;
                    if (ACT == 1) {
#pragma unroll
                        for (int e = 0; e < 4; ++e) { const float a = fmaxf(v0[e], 0.f), b = fmaxf(v1[e], 0.f); v0[e] = a * a; v1[e] = b * b; }
                    }
                    u32x4 w; w.x = cvt_pk_bf16(v0[0], v0[1]); w.y = cvt_pk_bf16(v0[2], v0[3]); w.z = cvt_pk_bf16(v1[0], v1[1]); w.w = cvt_pk_bf16(v1[2], v1[3]);
                    *(u32x4*)(rowp + bj * HALF) = w;
                }
            }
    }
};
struct EpiResidual {
    static constexpr bool PERM = false, AFTER_DRAIN = false;
    const float* xin_p; const float* xin_s; int split_row;
    float* Xout; bf16_t* xb; float* ssq;
    __device__ __forceinline__ void operator()(const f32x4 (&acc)[2][2][4][2], const Unit& u, int wr, int wc, int fr, int fq) const {
        typedef unsigned u32x2v __attribute__((ext_vector_type(2)));
        const int col0 = u.pn * BM + wc * 32 + 4 * fq;
#pragma unroll
        for (int ai = 0; ai < 2; ++ai)
#pragma unroll
            for (int m = 0; m < 4; ++m) {
                const int row = u.pm * BM + ai * HALF + wr * 64 + m * 16 + fr;
                const float* src = (row < split_row) ? xin_p + (size_t)row * 1024 : xin_s + (size_t)(row - split_row) * 1024;
                float q = 0.f;
#pragma unroll
                for (int bj = 0; bj < 2; ++bj)
#pragma unroll
                    for (int n = 0; n < 2; ++n) {
                        const int off = col0 + bj * HALF + n * 16;
                        const f32x4 o = *(const f32x4*)(src + off) + acc[ai][bj][m][n];
                        *(f32x4*)(Xout + (size_t)row * 1024 + off) = o;
                        u32x2v w; w.x = cvt_pk_bf16(o[0], o[1]); w.y = cvt_pk_bf16(o[2], o[3]);
                        *(u32x2v*)(xb + (size_t)row * 1024 + off) = w;
                        q += (o[0] * o[0] + o[1] * o[1]) + (o[2] * o[2] + o[3] * o[3]);
                    }
                q += __shfl_xor(q, 16); q += __shfl_xor(q, 32);
                if (fq == 0) ssq[(size_t)row * 16 + u.pn * 4 + wc] = q;
            }
    }
};
template <class Epi, class Sched, bool ALIGN_EPI = false, bool SP2 = false>
__device__ __forceinline__ void gemm_phase(PG8_LAS unsigned char* lds, const Gemm g, const Sched& S, const Epi& E) {
    const int tid = threadIdx.x, wid = __builtin_amdgcn_readfirstlane(tid >> 6), lane = tid & 63, wr = wid >> 2, wc = wid & 3, fr = lane & 15, fq = lane >> 4;
    const int K = g.K, nt = K / BK;
    unsigned voffA[2], voffB[2];
#pragma unroll
    for (int i = 0; i < 2; ++i) { int R, C; stage_rc(tid * 16 + i * 8192, R, C); const int Rb = Epi::PERM ? ((R & ~31) + perm32(R & 31)) : R;
        voffA[i] = (unsigned)(R * K + C) * 2u; voffB[i] = (unsigned)(Rb * K + C) * 2u; }
    const size_t kstep = (size_t)(BK * 2);
    const size_t hstep = (size_t)HALF * K * 2;
    const size_t tstep = 2 * hstep;
    const unsigned ldsw = (unsigned)wid * 1024u;
    const int aoff = lds_byte(wr * 64 + fr, fq * 8), boff = lds_byte(wc * 32 + fr, fq * 8);
#define PG8_SA(b, h) (((b) * 2 + (h)) * HTB)
#define PG8_SB(b, h) ((4 + (b) * 2 + (h)) * HTB)
#define PG8_STAGE(bufoff, gbase, voff) do { _Pragma("unroll") for (int _i = 0; _i < 2; ++_i) \
        __builtin_amdgcn_global_load_lds((const unsigned*)((const char*)(gbase) + (voff)[_i]), (PG8_LAS unsigned*)(lds + (bufoff) + ldsw + _i * 8192), 16, 0, 0); } while (0)
#define PG8_LDA(dst, b, h) do { _Pragma("unroll") for (int m = 0; m < 4; ++m) _Pragma("unroll") for (int k = 0; k < 2; ++k) dst[m][k] = *(const PG8_LAS bf16x8*)(lds + PG8_SA(b, h) + aoff + m * 2048 + k * 1024); } while (0)
#define PG8_LDB(dst, b, h) do { _Pragma("unroll") for (int n = 0; n < 2; ++n) _Pragma("unroll") for (int k = 0; k < 2; ++k) dst[n][k] = *(const PG8_LAS bf16x8*)(lds + PG8_SB(b, h) + boff + n * 2048 + k * 1024); } while (0)
#define PG8_MMA(ai, bj, At, Bt) do { __builtin_amdgcn_s_setprio(1); _Pragma("unroll") for (int m = 0; m < 4; ++m) _Pragma("unroll") for (int n = 0; n < 2; ++n) _Pragma("unroll") for (int k = 0; k < 2; ++k) \
        acc[ai][bj][m][n] = __builtin_amdgcn_mfma_f32_16x16x32_bf16(Bt[n][k], At[m][k], acc[ai][bj][m][n], 0, 0, 0); __builtin_amdgcn_s_setprio(0); } while (0)
#define PG8_WAIT_V(n) asm volatile("s_waitcnt vmcnt(" #n ")" ::: "memory")
#define PG8_WAIT_L(n) asm volatile("s_waitcnt lgkmcnt(" #n ")" ::: "memory")
#define PG8_BAR __builtin_amdgcn_s_barrier()
#define PG8_SCHED __builtin_amdgcn_sched_barrier(0)
    Unit cur, nxt; int ui = 0;
    if (!S.next(0, cur)) return;
    f32x4 acc[2][2][4][2];
#pragma unroll
    for (int a = 0; a < 2; ++a)
#pragma unroll
        for (int b = 0; b < 2; ++b)
#pragma unroll
            for (int m = 0; m < 4; ++m)
#pragma unroll
                for (int n = 0; n < 2; ++n) acc[a][b][m][n] = (f32x4){0.f, 0.f, 0.f, 0.f};
    bf16x8 At[4][2], B0[2][2], B1[2][2];
    const char* cA = (const char*)g.A + (size_t)cur.pm * tstep; const char* cB = (const char*)g.Bt + (size_t)cur.pn * tstep;
    S.a_ready(cur);
    if constexpr (SP2) {
        PG8_STAGE(PG8_SB(0, 0), cB, voffB); PG8_STAGE(PG8_SB(0, 1), cB + hstep, voffB); PG8_STAGE(PG8_SA(0, 0), cA, voffA); PG8_STAGE(PG8_SA(0, 1), cA + hstep, voffA);
        if (wr == 1) PG8_BAR;
        PG8_WAIT_V(2); PG8_BAR;
        PG8_STAGE(PG8_SB(1, 0), cB + kstep, voffB); PG8_STAGE(PG8_SA(1, 0), cA + kstep, voffA); PG8_STAGE(PG8_SB(1, 1), cB + hstep + kstep, voffB);
        PG8_WAIT_V(6); PG8_BAR;
    } else {
        PG8_STAGE(PG8_SB(0, 0), cB, voffB); PG8_STAGE(PG8_SA(0, 0), cA, voffA); PG8_STAGE(PG8_SB(0, 1), cB + hstep, voffB); PG8_STAGE(PG8_SA(0, 1), cA + hstep, voffA);
        if (wr == 1) PG8_BAR;
        PG8_WAIT_V(4); PG8_BAR;
        PG8_STAGE(PG8_SB(1, 0), cB + kstep, voffB); PG8_STAGE(PG8_SA(1, 0), cA + kstep, voffA); PG8_STAGE(PG8_SB(1, 1), cB + hstep + kstep, voffB);
        PG8_WAIT_V(6); PG8_BAR;
    }
    for (;;) {
        const bool has_next = S.next(ui + 1, nxt);
        const char* nA = has_next ? (const char*)g.A + (size_t)nxt.pm * tstep : cA; const char* nB = has_next ? (const char*)g.Bt + (size_t)nxt.pn * tstep : cB;
        for (int t = 0; t < nt; t += 2) {
            const bool last = (t == nt - 2);
            const char* a1 = cA + (size_t)(t + 1) * kstep;
            const char* a2 = last ? nA : cA + (size_t)(t + 2) * kstep; const char* b2 = last ? nB : cB + (size_t)(t + 2) * kstep;
            const char* a3 = a2 + kstep; const char* b3 = b2 + kstep;
            if (last && has_next) S.a_ready(nxt);
            if constexpr (SP2) {
            PG8_LDB(B0, 0, 0); PG8_LDB(B1, 0, 1); PG8_SCHED; PG8_LDA(At, 0, 0); PG8_STAGE(PG8_SA(1, 1), a1 + hstep, voffA);
            PG8_WAIT_V(8); PG8_WAIT_L(0); PG8_BAR; PG8_MMA(0, 0, At, B0); PG8_MMA(0, 1, At, B1); PG8_BAR; PG8_SCHED;
            PG8_LDA(At, 0, 1); PG8_STAGE(PG8_SB(0, 0), b2, voffB); PG8_STAGE(PG8_SB(0, 1), b2 + hstep, voffB); PG8_STAGE(PG8_SA(0, 0), a2, voffA);
            PG8_WAIT_V(8); PG8_WAIT_L(0); PG8_BAR; PG8_MMA(1, 0, At, B0); PG8_MMA(1, 1, At, B1); PG8_BAR; PG8_SCHED;
            PG8_LDB(B0, 1, 0); PG8_LDB(B1, 1, 1); PG8_SCHED; PG8_LDA(At, 1, 0); PG8_STAGE(PG8_SA(0, 1), a2 + hstep, voffA);
            PG8_WAIT_V(8); PG8_WAIT_L(0); PG8_BAR; PG8_MMA(0, 0, At, B0); PG8_MMA(0, 1, At, B1); PG8_BAR; PG8_SCHED;
            PG8_LDA(At, 1, 1); PG8_STAGE(PG8_SB(1, 0), b3, voffB); PG8_STAGE(PG8_SB(1, 1), b3 + hstep, voffB); PG8_STAGE(PG8_SA(1, 0), a3, voffA);
            PG8_WAIT_V(8); PG8_WAIT_L(0); PG8_BAR; PG8_MMA(1, 0, At, B0); PG8_MMA(1, 1, At, B1); PG8_BAR; PG8_SCHED;
            } else {
            PG8_LDB(B0, 0, 0); PG8_SCHED; PG8_LDA(At, 0, 0); PG8_STAGE(PG8_SA(1, 1), a1 + hstep, voffA);
            PG8_WAIT_L(8); PG8_BAR; PG8_WAIT_L(0); PG8_MMA(0, 0, At, B0); PG8_BAR; PG8_SCHED;
            PG8_LDB(B1, 0, 1); PG8_STAGE(PG8_SB(0, 0), b2, voffB);
            PG8_BAR; PG8_WAIT_L(0); PG8_MMA(0, 1, At, B1); PG8_BAR;
            PG8_LDA(At, 0, 1); PG8_STAGE(PG8_SA(0, 0), a2, voffA);
            PG8_BAR; PG8_WAIT_L(0); PG8_MMA(1, 0, At, B0); PG8_BAR; PG8_SCHED;
            PG8_STAGE(PG8_SB(0, 1), b2 + hstep, voffB);
            PG8_WAIT_V(6); PG8_BAR; PG8_MMA(1, 1, At, B1); PG8_BAR;
            PG8_LDB(B0, 1, 0); PG8_SCHED; PG8_LDA(At, 1, 0); PG8_STAGE(PG8_SA(0, 1), a2 + hstep, voffA);
            PG8_WAIT_L(8); PG8_BAR; PG8_WAIT_L(0); PG8_MMA(0, 0, At, B0); PG8_BAR; PG8_SCHED;
            PG8_LDB(B1, 1, 1); PG8_STAGE(PG8_SB(1, 0), b3, voffB);
            PG8_BAR; PG8_WAIT_L(0); PG8_MMA(0, 1, At, B1); PG8_BAR;
            PG8_LDA(At, 1, 1); PG8_STAGE(PG8_SA(1, 0), a3, voffA);
            PG8_BAR; PG8_WAIT_L(0); PG8_MMA(1, 0, At, B0); PG8_BAR; PG8_SCHED;
            PG8_STAGE(PG8_SB(1, 1), b3 + hstep, voffB);
            PG8_WAIT_V(6); PG8_BAR; PG8_MMA(1, 1, At, B1); PG8_BAR;
            }
        }
        if constexpr (ALIGN_EPI) { if (wr == 0) PG8_BAR; }
        if constexpr (!Epi::AFTER_DRAIN) { E(acc, cur, wr, wc, fr, fq); S.done(cur); }
        if (!has_next) break;
#pragma unroll
        for (int a = 0; a < 2; ++a)
#pragma unroll
            for (int b = 0; b < 2; ++b)
#pragma unroll
                for (int m = 0; m < 4; ++m)
#pragma unroll
                    for (int n = 0; n < 2; ++n) acc[a][b][m][n] = (f32x4){0.f, 0.f, 0.f, 0.f};
        cur = nxt; cA = nA; cB = nB; ++ui;
        if constexpr (ALIGN_EPI) { if (wr == 1) PG8_BAR; }
    }
    PG8_WAIT_V(0);
    if constexpr (!ALIGN_EPI) { if (wr == 0) PG8_BAR; }
    PG8_BAR;
    if constexpr (Epi::AFTER_DRAIN) { E.fused(acc, cur, wr, wc, fr, fq, lds, wid, lane); S.done(cur); }
#undef PG8_SA
#undef PG8_SB
#undef PG8_STAGE
#undef PG8_LDA
#undef PG8_LDB
#undef PG8_MMA
#undef PG8_WAIT_V
#undef PG8_WAIT_L
#undef PG8_BAR
#undef PG8_SCHED
}
}
#define GAS __attribute__((address_space(1)))
#define LAS __attribute__((address_space(3)))
typedef unsigned short bf16;
typedef unsigned v4u __attribute__((ext_vector_type(4)));
typedef float f32x4 __attribute__((ext_vector_type(4)));
typedef short bf16x8 __attribute__((ext_vector_type(8)));
typedef GAS unsigned gu32;
typedef GAS unsigned long long gu64;
#define RLX_AGENT __ATOMIC_RELAXED, __HIP_MEMORY_SCOPE_AGENT
#define LDS_WAIT() asm volatile("s_waitcnt lgkmcnt(0)" ::: "memory")
#define VM_WAIT() asm volatile("s_waitcnt vmcnt(0)" ::: "memory")
__device__ __forceinline__ unsigned long long rt() { return __builtin_amdgcn_s_memrealtime(); }
__device__ __forceinline__ unsigned f2bf(float f) { unsigned u = __builtin_bit_cast(unsigned, f); return (u + 0x7fffu + ((u >> 16) & 1u)) >> 16; }
__device__ __forceinline__ unsigned pk2(float lo, float hi) { return f2bf(lo) | (f2bf(hi) << 16); }

#define XB_TMO      128
#define XB_XCNT(j)  (256  + 64 * (j))
#define XB_XSUB(j)  (1280 + 64 * (j))
#define XB_XGEN(j)  (2304 + 64 * (j))
#define XB_TOP      3328
#define XB_TOPGEN   3392
#define XCD_BAR_WORDS 3456
#define XB_SPIN_CAP (1u << 18)

__device__ __forceinline__ unsigned xb_ld(unsigned* p)              { return __hip_atomic_load(p, __ATOMIC_RELAXED, __HIP_MEMORY_SCOPE_AGENT); }
__device__ __forceinline__ unsigned xb_add(unsigned* p, unsigned v) { return __hip_atomic_fetch_add(p, v, __ATOMIC_RELAXED, __HIP_MEMORY_SCOPE_AGENT); }
__device__ __forceinline__ unsigned xb_xcc_id() { return (unsigned)__builtin_amdgcn_s_getreg((3 << 11) | 20) & 0xFu; }
#define XB_SPIN(cond, bar) do { unsigned _sp = 0; while (cond) { __builtin_amdgcn_s_sleep(1); \
    if ((++_sp & 255u) == 0u) { if (xb_ld(&(bar)[XB_TMO])) break; if (_sp > XB_SPIN_CAP) { atomicAdd(&(bar)[XB_TMO], 1u); break; } } } } while (0)

struct XcdBarrier {
    unsigned* bar; unsigned x;
    volatile LAS unsigned* st;
};

__device__ __forceinline__ XcdBarrier xcd_barrier_post(unsigned* bar, volatile LAS unsigned* st) {
    XcdBarrier b; b.bar = bar; b.x = xb_xcc_id(); b.st = st;
    if (threadIdx.x == 0) (void)xb_add(&bar[XB_XCNT(b.x)], 1u);
    return b;
}
__device__ __forceinline__ void xcd_barrier_complete(unsigned* bar, unsigned x, unsigned& nloc, unsigned& nx) {
    const unsigned G = gridDim.x * gridDim.y * gridDim.z;
    unsigned sum, cnt, mine, sp = 0u;
    for (;;) {
        sum = 0u; cnt = 0u; mine = 0u;
#pragma unroll
        for (unsigned j = 0; j < 16; ++j) { const unsigned c = xb_ld(&bar[XB_XCNT(j)]); sum += c; cnt += (c > 0u) ? 1u : 0u; mine = (j == x) ? c : mine; }
        if (sum == G) break;
        __builtin_amdgcn_s_sleep(1);
        if ((++sp & 255u) == 0u) { if (xb_ld(&bar[XB_TMO])) break; if (sp > XB_SPIN_CAP) { atomicAdd(&bar[XB_TMO], 1u); break; } }
    }
    nloc = mine > 0u ? mine : 1u; nx = cnt > 0u ? cnt : 1u;
}

__device__ __forceinline__ void xcd_barrier(const XcdBarrier& b) {
    asm volatile("s_waitcnt vmcnt(0)" ::: "memory");
    __syncthreads();
    if (threadIdx.x == 0) {
        unsigned* bar = b.bar;
        __builtin_amdgcn_s_waitcnt(0);
        unsigned nloc = b.st[0], nx = b.st[1];
        if (nloc == 0u) { xcd_barrier_complete(bar, b.x, nloc, nx); b.st[0] = nloc; b.st[1] = nx; }
        const unsigned old = xb_add(&bar[XB_XSUB(b.x)], 1u);
        const unsigned gen = old / nloc;
        if (old + 1u == (gen + 1u) * nloc) {
            __builtin_amdgcn_fence(__ATOMIC_RELEASE, "agent");
            asm volatile("s_waitcnt vmcnt(0)" ::: "memory");
            const unsigned og = xb_add(&bar[XB_TOP], 1u);
            const unsigned tg = og / nx;
            if (og + 1u == (tg + 1u) * nx) xb_add(&bar[XB_TOPGEN], 1u);
            else XB_SPIN(xb_ld(&bar[XB_TOPGEN]) == tg, bar);
            __builtin_amdgcn_fence(__ATOMIC_ACQUIRE, "agent");
            xb_add(&bar[XB_XGEN(b.x)], 1u);
            asm volatile("s_waitcnt vmcnt(0)" ::: "memory");
        } else {
            XB_SPIN(xb_ld(&bar[XB_XGEN(b.x)]) == gen, bar);
            __builtin_amdgcn_fence(__ATOMIC_ACQUIRE, "agent");
            asm volatile("s_waitcnt vmcnt(0)" ::: "memory");
        }
    }
    __syncthreads();
}
constexpr int NWAVES = 8;
#ifndef MK_PER_PHASE
#define MK_PER_PHASE 1
#endif
constexpr int D = 1024, MP = 16384, MS = 1024, M = MP + MS, NPROJ = 2816, FF = 4096, NIN = 2820;
constexpr int SEQ = 2048, NB = 8, SB = 128, SL = 8, NCH = 32  ;
constexpr float EPS = 1e-6f;
constexpr size_t MiB = 1u << 20;
constexpr size_t WS_CTL = 0, CTL_ZERO_BYTES = 256 * 1024;
constexpr size_t WS_WDT = 512 * 1024;
constexpr size_t WS_WIN = 1 * MiB;
constexpr size_t WS_WOUT = 12 * MiB;
constexpr size_t WS_WUP = 16 * MiB;
constexpr size_t WS_WDN = 32 * MiB;
constexpr size_t WS_XB = 48 * MiB;
constexpr size_t WS_UP = 82 * MiB;
constexpr size_t WS_PROJ = 82 * MiB;
constexpr size_t WS_SSDLOC = 176 * MiB;
constexpr size_t WS_HGLOC = 192 * MiB;
constexpr size_t WS_MIX = 218 * MiB;
constexpr size_t WS_SSQA = 252 * MiB;
constexpr size_t WS_SSQB = 253 * MiB + 512 * 1024;
constexpr size_t WS_SMALL = 255 * MiB;
constexpr size_t WS_END = 256 * MiB;
static_assert(WS_UP + (size_t)M * FF * 2 <= WS_MIX && WS_PROJ + (size_t)M * NPROJ * 2 <= WS_SSDLOC && WS_MIX + (size_t)M * D * 2 <= WS_SSQA && WS_SSQA + (size_t)M * 64 <= WS_SSQB && WS_SSQB + (size_t)M * 64 <= WS_SMALL, "ws map");
constexpr int CW_BAR = 4096;
constexpr int CW_QUEUE = 16384;
constexpr size_t O_Y = 0, O_PK = 17825792, O_PV = O_PK + 262144, O_PSSM = O_PV + 262144, O_PSSMC = O_PSSM + 262144, O_PHG = O_PSSMC + 24576,
                 O_PLRU = O_PHG + 262144, O_PLRUC = O_PLRU + 4096, O_SK = O_PLRUC + 12288, O_SV = O_SK + 4194304, O_SSSM = O_SV + 4194304,
                 O_SSSMC = O_SSSM + 4194304, O_SHG = O_SSSMC + 393216, O_SLRU = O_SHG + 4194304, O_SLRUC = O_SLRU + 65536, O_END = O_SLRUC + 196608;
constexpr int RING_BYTES = 131072, LDSCTL_OFF = RING_BYTES, MISC_OFF = LDSCTL_OFF + 320, SSQ_LDS_OFF = LDSCTL_OFF + 1024, WSCR_OFF = LDSCTL_OFF + 4096, LDS_BYTES = 147456;

typedef unsigned v2u __attribute__((ext_vector_type(2)));

__device__ __forceinline__ float bf2f(unsigned short u) { return __builtin_bit_cast(float, (unsigned)u << 16); }
__device__ __forceinline__ float bflo(unsigned u) { return __builtin_bit_cast(float, u << 16); }
__device__ __forceinline__ float bfhi(unsigned u) { return __builtin_bit_cast(float, u & 0xffff0000u); }
__device__ __forceinline__ unsigned short f2bf_s(float f) { return (unsigned short)f2bf(f); }
__device__ __forceinline__ float wave_sum(float v) {
#pragma unroll
    for (int o = 1; o < 64; o <<= 1) v += __shfl_xor(v, o);
    return v;
}
__device__ __forceinline__ float rdlane(float v, int l) { return __builtin_bit_cast(float, __builtin_amdgcn_readlane(__builtin_bit_cast(int, v), l)); }
__device__ __forceinline__ float sigmoidf_(float x) { return 1.0f / (1.0f + __expf(-x)); }
__device__ __forceinline__ float siluf_(float x) { return x / (1.0f + __expf(-x)); }
__device__ __forceinline__ float softplusf_(float x) { return x > 20.f ? x : log1pf(__expf(x)); }
__device__ __forceinline__ float geluf_(float x) { const float u = 0.7978845608028654f * (x + 0.044715f * x * x * x); return 0.5f * x * (1.0f + tanhf(u)); }

#define OPQ(p) asm volatile("" : "+v"(p))
__device__ __forceinline__ void ld64s(float (&v)[64], const float* p) {
#pragma unroll
    for (int i0 = 0; i0 < 64; i0 += 8) {
#pragma unroll
        for (int i = 0; i < 8; ++i) v[i0 + i] = p[i * 64];
        p += 512; OPQ(p); }
}
__device__ __forceinline__ void st64s(const float (&v)[64], float* p) {
#pragma unroll
    for (int i0 = 0; i0 < 64; i0 += 8) {
#pragma unroll
        for (int i = 0; i < 8; ++i) p[i * 64] = v[i0 + i];
        p += 512; OPQ(p); }
}
struct Frame {
    LAS unsigned char* lds;
    volatile LAS unsigned* MISC;
    gu32* ctl;
    int tid, lane, wave, vcu, G;
    const float* const* in;
    float* out; unsigned char* ws;
};
#define PIN(i) (F.in[i])
enum { I_XP = 0, I_XS, I_CK, I_CV, I_SSSM, I_SSSMC, I_SHG, I_SLRU, I_SLRUC, I_NMIX, I_WIN, I_SCW, I_SCB, I_SDTB, I_SALOG, I_SD, I_SNW, I_SINK, I_RELB, I_HLB, I_HNW,
       I_LCW, I_LCB, I_LWA, I_LBA, I_LWX, I_LBX, I_LLAM, I_WOUT, I_NMLP, I_WUP, I_WDN, I_NF };

__device__ __forceinline__ void p0_transpose_item(const float* W, int K, int Nsrc, bf16* WT, int n_dst0, int n_src0, int k0, const float* scale, LAS float* scr, int lane) {
#pragma unroll 8
    for (int i = 0; i < 32; ++i) { const int kk = 2 * i + (lane >> 5); const float sc = scale ? scale[k0 + kk] : 1.0f; scr[kk * 33 + (lane & 31)] = W[(size_t)(k0 + kk) * Nsrc + n_src0 + (lane & 31)] * sc; }
    LDS_WAIT(); asm volatile("" ::: "memory");
    const int c = lane & 7;
#pragma unroll
    for (int j = 0; j < 4; ++j) { const int n = (lane >> 3) + 8 * j; const LAS float* s = scr + (8 * c) * 33 + n;
        v4u o; o.x = pk2(s[0 * 33], s[1 * 33]); o.y = pk2(s[2 * 33], s[3 * 33]); o.z = pk2(s[4 * 33], s[5 * 33]); o.w = pk2(s[6 * 33], s[7 * 33]);
        *(v4u*)(WT + (size_t)(n_dst0 + n) * K + k0 + 8 * c) = o; }
    LDS_WAIT(); asm volatile("" ::: "memory");
}
__device__ __forceinline__ void p0_prologue(Frame& F) {
    LAS float* scr = (LAS float*)(F.lds + F.wave * 16384);
    const int gw = F.vcu * NWAVES + F.wave, NGW = F.G * NWAVES;
    constexpr int I_IN = 16 * 88, I_OUT = 16 * 32, I_UP = 16 * 128, I_DN = 64 * 32, I_L = I_IN + I_OUT + I_UP + I_DN;
    for (int it = gw; it < 2 * I_L; it += NGW) {
        const int l = it / I_L; int r = it % I_L;
        if (r < I_IN) { const int kb = r / 88, nb = r % 88, nd = 32 * nb, ns = nd < 768 ? nd : nd + 4;
            p0_transpose_item(PIN(I_WIN) + (size_t)l * D * NIN, D, NIN, (bf16*)(F.ws + WS_WIN) + (size_t)l * NPROJ * D, nd, ns, 64 * kb, PIN(I_NMIX) + l * D, scr, F.lane); continue; } r -= I_IN;
        if (r < I_OUT) { const int kb = r / 32, nb = r % 32;
            p0_transpose_item(PIN(I_WOUT) + (size_t)l * D * D, D, D, (bf16*)(F.ws + WS_WOUT) + (size_t)l * D * D, 32 * nb, 32 * nb, 64 * kb, nullptr, scr, F.lane); continue; } r -= I_OUT;
        if (r < I_UP) { const int kb = r / 128, nb = r % 128;
            p0_transpose_item(PIN(I_WUP) + (size_t)l * D * FF, D, FF, (bf16*)(F.ws + WS_WUP) + (size_t)l * FF * D, 32 * nb, 32 * nb, 64 * kb, PIN(I_NMLP) + l * D, scr, F.lane); continue; } r -= I_UP;
        { const int kb = r / 32, nb = r % 32;
            p0_transpose_item(PIN(I_WDN) + (size_t)l * FF * D, FF, D, (bf16*)(F.ws + WS_WDN) + (size_t)l * D * FF, 32 * nb, 32 * nb, 64 * kb, nullptr, scr, F.lane); }
    }
    for (int e = gw * 64 + F.lane; e < 2 * 4 * D; e += NGW * 64) { const int l = e / (4 * D), h = (e / D) % 4, k = e % D;
        ((float*)(F.ws + WS_WDT))[e] = PIN(I_NMIX)[l * D + k] * PIN(I_WIN)[(size_t)l * D * NIN + (size_t)k * NIN + 768 + h]; }
    bf16* xb = (bf16*)(F.ws + WS_XB); float* ssq = (float*)(F.ws + WS_SSQA);
    for (int m = gw; m < M; m += NGW) {
        const float* xrow = (m < MP) ? PIN(I_XP) + (size_t)m * D : PIN(I_XS) + (size_t)(m - MP) * D;
        const f32x4* xr = (const f32x4*)xrow + F.lane; float s = 0.f;
        unsigned long long* o8 = (unsigned long long*)(xb + (size_t)m * D) + F.lane;
#pragma unroll
        for (int j = 0; j < 4; ++j) { const f32x4 v = xr[64 * j]; s += (v.x * v.x + v.y * v.y) + (v.z * v.z + v.w * v.w);
            o8[64 * j] = (unsigned long long)pk2(v.x, v.y) | ((unsigned long long)pk2(v.z, v.w) << 32); }
        s = wave_sum(s);
        if (F.lane < 16) ssq[(size_t)m * 16 + F.lane] = (F.lane == 0) ? s : 0.f;
    }
}
__device__ __forceinline__ void final_norm(Frame& F) {
    const int gw = F.vcu * NWAVES + F.wave, NGW = F.G * NWAVES;
    const float* ssq = (const float*)(F.ws + WS_SSQA);
    for (int m = gw; m < M; m += NGW) {
        float s = ssq[(size_t)m * 16 + (F.lane & 15)]; s += __shfl_xor(s, 1); s += __shfl_xor(s, 2); s += __shfl_xor(s, 4); s += __shfl_xor(s, 8);
        const float rs = 1.0f / sqrtf(s * (1.0f / D) + EPS);
        f32x4* xr = (f32x4*)(F.out + (size_t)m * D) + F.lane; const f32x4* wv = (const f32x4*)PIN(I_NF) + F.lane;
#pragma unroll
        for (int j = 0; j < 4; ++j) { f32x4 v = xr[64 * j]; const f32x4 w = wv[64 * j]; v = v * rs * w; xr[64 * j] = v; }
    }
}

__device__ __forceinline__ float row_rstd(const float* ssq, int row, int lane) {
    float s = ssq[(size_t)row * 16 + (lane & 15)]; s += __shfl_xor(s, 1); s += __shfl_xor(s, 2); s += __shfl_xor(s, 4); s += __shfl_xor(s, 8);
    return 1.0f / sqrtf(s * (1.0f / D) + EPS);
}
#define PROJ(F) ((const bf16*)((F).ws + WS_PROJ))
template <bool WRITE_Y>
__device__ __forceinline__ void ssd_wave(Frame& F, int l, int h, int row0, int nsteps, int hist, const float* cs, float (&S)[64], float& logdec,
                                         LAS float* ylds  , LAS float* ssql  ) {
    const int lane = F.lane, g = h >> 1;
    const int cx = h * 64 + lane, cB = 256 + g * 64 + lane, cC = 384 + g * 64 + lane;
    const float* cw = PIN(I_SCW) + (size_t)l * 4 * 512; const float* cb = PIN(I_SCB) + (size_t)l * 512;
    float wx[4], wB[4], wC[4];
#pragma unroll
    for (int k = 0; k < 4; ++k) { wx[k] = cw[k * 512 + cx]; wB[k] = cw[k * 512 + cB]; wC[k] = cw[k * 512 + cC]; }
    const float bx = cb[cx], bB = cb[cB], bC = cb[cC];
    const float A = -__expf(PIN(I_SALOG)[l * 4 + h]), Dh = PIN(I_SD)[l * 4 + h], dtb = PIN(I_SDTB)[l * 4 + h];
    const bf16* proj = PROJ(F); const bf16* xb = (const bf16*)(F.ws + WS_XB); const float* ssq = (const float*)(F.ws + WS_SSQA);
    float dtv = 0.f;
    {
        const float* wd = (const float*)(F.ws + WS_WDT) + (size_t)(l * 4 + h) * D + lane * 16;
        float w[16];
#pragma unroll
        for (int i = 0; i < 16; ++i) w[i] = wd[i];
#pragma unroll 1
        for (int t = 0; t < nsteps; ++t) {
            const int row = row0 + t;
            const v4u a = *(const v4u*)(xb + (size_t)row * D + lane * 16), b = *(const v4u*)(xb + (size_t)row * D + lane * 16 + 8);
            float s = bflo(a.x) * w[0] + bfhi(a.x) * w[1] + bflo(a.y) * w[2] + bfhi(a.y) * w[3] + bflo(a.z) * w[4] + bfhi(a.z) * w[5] + bflo(a.w) * w[6] + bfhi(a.w) * w[7]
                    + bflo(b.x) * w[8] + bfhi(b.x) * w[9] + bflo(b.y) * w[10] + bfhi(b.y) * w[11] + bflo(b.z) * w[12] + bfhi(b.z) * w[13] + bflo(b.w) * w[14] + bfhi(b.w) * w[15];
            s = wave_sum(s);
            const float dt = softplusf_(s * row_rstd(ssq, row, lane) + dtb);
            if (lane == t) dtv = dt;
        }
    }
    float x1 = 0.f, x2 = 0.f, x3 = 0.f, B1 = 0.f, B2 = 0.f, B3 = 0.f, C1 = 0.f, C2 = 0.f, C3 = 0.f;
    if (hist == 1) {
        const bf16* p = proj + (size_t)(row0 - 1) * NPROJ + 256;
        x1 = bf2f(p[cx]); B1 = bf2f(p[cB]); C1 = bf2f(p[cC]); p -= NPROJ; x2 = bf2f(p[cx]); B2 = bf2f(p[cB]); C2 = bf2f(p[cC]); p -= NPROJ; x3 = bf2f(p[cx]); B3 = bf2f(p[cB]); C3 = bf2f(p[cC]);
    } else if (hist == 2) {
        x3 = cs[cx]; B3 = cs[cB]; C3 = cs[cC]; x2 = cs[512 + cx]; B2 = cs[512 + cB]; C2 = cs[512 + cC]; x1 = cs[1024 + cx]; B1 = cs[1024 + cB]; C1 = cs[1024 + cC];
    }
    LAS float* bc = (LAS float*)(F.lds + WSCR_OFF) + F.wave * 256;
    const int last = nsteps - 1;
#define SSD_LOAD(xv, Bv, Cv, zv, tt) do { const bf16* p_ = proj + (size_t)(row0 + ((tt) < last ? (tt) : last)) * NPROJ; xv = bf2f(p_[256 + cx]); Bv = bf2f(p_[256 + cB]); Cv = bf2f(p_[256 + cC]); zv = WRITE_Y ? bf2f(p_[cx]) : 0.f; } while (0)
    float xa, Ba, Ca, za, xn, Bn, Cn, zn, xm, Bm, Cm, zm;
    SSD_LOAD(xa, Ba, Ca, za, 0); SSD_LOAD(xn, Bn, Cn, zn, 1);
#pragma unroll 1
    for (int t = 0; t < nsteps; ++t) {
        SSD_LOAD(xm, Bm, Cm, zm, t + 2);
        const float xc = bx + wx[0] * x3 + wx[1] * x2 + wx[2] * x1 + wx[3] * xa; x3 = x2; x2 = x1; x1 = xa;
        const float Bc = bB + wB[0] * B3 + wB[1] * B2 + wB[2] * B1 + wB[3] * Ba; B3 = B2; B2 = B1; B1 = Ba;
        const float Cc = bC + wC[0] * C3 + wC[1] * C2 + wC[2] * C1 + wC[3] * Ca; C3 = C2; C2 = C1; C1 = Ca;
        const float xs = siluf_(xc);
        bc[lane] = siluf_(Bc); if (WRITE_Y) bc[64 + lane] = siluf_(Cc);
        const float dt = rdlane(dtv, t), dA = __expf(dt * A), xdt = xs * dt;
        logdec += dt * A;
        float y0 = 0.f, y1 = 0.f;
#pragma unroll
        for (int n = 0; n < 64; n += 4) {
            const f32x4 bv = *(const LAS f32x4*)(bc + n);
            S[n] = dA * S[n] + xdt * bv.x; S[n + 1] = dA * S[n + 1] + xdt * bv.y; S[n + 2] = dA * S[n + 2] + xdt * bv.z; S[n + 3] = dA * S[n + 3] + xdt * bv.w;
            if (WRITE_Y) { const f32x4 cv = *(const LAS f32x4*)(bc + 64 + n); y0 += S[n] * cv.x + S[n + 2] * cv.z; y1 += S[n + 1] * cv.y + S[n + 3] * cv.w; }
        }
        if (WRITE_Y) {
            const float yg = ((y0 + y1) + Dh * xs) * siluf_(za);
            ylds[t * 256 + cx] = yg;
            const float q = wave_sum(yg * yg);
            if (lane == 0) ssql[t * 4 + h] = q;
        }
        xa = xn; Ba = Bn; Ca = Cn; za = zn; xn = xm; Bn = Bm; Cn = Cm; zn = zm;
    }
#undef SSD_LOAD
}
__device__ __forceinline__ void ssd_norm_store(Frame& F, int l, int h, int row0, int nsteps, const LAS float* ylds, const LAS float* ssql) {
    const int cx = h * 64 + F.lane; const float nw = PIN(I_SNW)[l * 256 + cx];
    bf16* mix = (bf16*)(F.ws + WS_MIX);
#pragma unroll 1
    for (int t = 0; t < nsteps; ++t) {
        const float q = (ssql[t * 4] + ssql[t * 4 + 1]) + (ssql[t * 4 + 2] + ssql[t * 4 + 3]);
        const float rs = 1.0f / sqrtf(q * (1.0f / 256.0f) + EPS);
        mix[(size_t)(row0 + t) * D + cx] = f2bf_s(ylds[t * 256 + cx] * rs * nw);
    }
}
__device__ __forceinline__ void ssd_conv_out(Frame& F, int h, int r0, float* dst) {
    const bf16* proj = PROJ(F); const int lane = F.lane, g = h >> 1;
#pragma unroll
    for (int j = 0; j < 3; ++j) { const bf16* p = proj + (size_t)(r0 + j) * NPROJ + 256; dst[j * 512 + h * 64 + lane] = bf2f(p[h * 64 + lane]);
        if ((h & 1) == 0) { dst[j * 512 + 256 + g * 64 + lane] = bf2f(p[256 + g * 64 + lane]); dst[j * 512 + 384 + g * 64 + lane] = bf2f(p[384 + g * 64 + lane]); } }
}
__device__ __forceinline__ void ssd_item(Frame& F, int l, int kind, int it) {
#ifdef SKIP_SSD
    return;
#endif
    const int w = F.wave, h = w & 3, half = w >> 2, lane = F.lane;
    LAS float* ylds = (LAS float*)F.lds + half * (64 * 256); LAS float* ssql = (LAS float*)(F.lds + SSQ_LDS_OFF) + half * 256;
    float* sloc = (float*)(F.ws + WS_SSDLOC); float* decS = (float*)(F.ws + WS_SMALL);
    float S[64]; float logdec = 0.f;
#pragma unroll
    for (int n = 0; n < 64; ++n) S[n] = 0.f;
    if (kind == 2) {
        const int b = it * 2 + half, row0 = MP + b * SL;
        const float* st = PIN(I_SSSM) + (((size_t)l * SB + b) * 4 + h) * 4096 + lane * 64;
#pragma unroll
        for (int n = 0; n < 64; n += 4) { const f32x4 v = *(const f32x4*)(st + n); S[n] = v.x; S[n + 1] = v.y; S[n + 2] = v.z; S[n + 3] = v.w; }
        ssd_wave<true>(F, l, h, row0, SL, 2, PIN(I_SSSMC) + ((size_t)l * SB + b) * 1536, S, logdec, ylds, ssql);
        float* so = F.out + O_SSSM + (((size_t)l * SB + b) * 4 + h) * 4096 + lane * 64;
#pragma unroll
        for (int n = 0; n < 64; n += 4) *(f32x4*)(so + n) = (f32x4){S[n], S[n + 1], S[n + 2], S[n + 3]};
        ssd_conv_out(F, h, row0 + SL - 3, F.out + O_SSSMC + ((size_t)l * SB + b) * 1536);
        __syncthreads();
        ssd_norm_store(F, l, h, row0, SL, ylds, ssql);
        __syncthreads();
        return;
    }
    const int b = it / 16, c = (it % 16) * 2 + half, row0 = b * SEQ + c * 64, sidx = (b * 4 + h) * NCH + c;
    if (kind == 0) {
        ssd_wave<false>(F, l, h, row0, 64, c == 0 ? 0 : 1, nullptr, S, logdec, ylds, ssql);
        st64s(S, sloc + (size_t)sidx * 4096 + lane);
        if (lane == 0) decS[sidx] = __expf(logdec);
        return;
    }
#pragma unroll 1
    for (int cc = 0; cc < c; ++cc) {
        const int si = (b * 4 + h) * NCH + cc; const float d = decS[si]; const float* sp = sloc + (size_t)si * 4096 + lane;
#pragma unroll
        for (int n0 = 0; n0 < 64; n0 += 8) {
#pragma unroll
            for (int n = 0; n < 8; ++n) S[n0 + n] = S[n0 + n] * d + sp[n * 64];
            sp += 512; OPQ(sp); }
    }
    ssd_wave<true>(F, l, h, row0, 64, c == 0 ? 0 : 1, nullptr, S, logdec, ylds, ssql);
    if (c == NCH - 1) {
        float* so = F.out + O_PSSM + (((size_t)l * NB + b) * 4 + h) * 4096 + lane * 64;
#pragma unroll
        for (int n = 0; n < 64; n += 4) *(f32x4*)(so + n) = (f32x4){S[n], S[n + 1], S[n + 2], S[n + 3]};
        ssd_conv_out(F, h, row0 + 61, F.out + O_PSSMC + ((size_t)l * NB + b) * 1536);
    }
    __syncthreads();
    ssd_norm_store(F, l, h, row0, 64, ylds, ssql);
    __syncthreads();
}

template <bool WRITE_Y>
__device__ __forceinline__ void hgrn_wave(Frame& F, int l, int h, int row0, int nsteps, float (&S)[64], float& decv) {
    const int lane = F.lane, ch = h * 64 + lane;
    const float lbk = (l == 0) ? 0.f : sigmoidf_(PIN(I_HLB)[256 + ch] - PIN(I_HLB)[ch]);
    const float nw = PIN(I_HNW)[l * 256 + ch];
    const bf16* proj = PROJ(F); bf16* mix = (bf16*)(F.ws + WS_MIX);
    LAS float* bc = (LAS float*)(F.lds + WSCR_OFF) + F.wave * 256;
    const int last = nsteps - 1;
#define HG_LOAD(qv_, fv_, iv_, gv_, tt) do { const bf16* p_ = proj + (size_t)(row0 + ((tt) < last ? (tt) : last)) * NPROJ + ch; qv_ = bf2f(p_[1280]); fv_ = bf2f(p_[1536]); iv_ = bf2f(p_[1792]); gv_ = WRITE_Y ? bf2f(p_[2048]) : 0.f; } while (0)
    float qa, fa, ia, ga, qn, fn, in_, gn, qm, fm, im, gm;
    HG_LOAD(qa, fa, ia, ga, 0); HG_LOAD(qn, fn, in_, gn, 1);
#pragma unroll 1
    for (int t = 0; t < nsteps; ++t) {
        HG_LOAD(qm, fm, im, gm, t + 2);
        const float sg = sigmoidf_(fa), f = lbk + (1.0f - lbk) * sg, kk = (1.0f - lbk) / (1.0f + __expf(fa)), iv = ia;
        decv *= f;
        bc[lane] = f; bc[64 + lane] = kk; if (WRITE_Y) bc[128 + lane] = qa;
        float o0 = 0.f, o1 = 0.f;
#pragma unroll
        for (int k = 0; k < 64; k += 4) {
            const f32x4 fv = *(const LAS f32x4*)(bc + k), kv = *(const LAS f32x4*)(bc + 64 + k);
            S[k] = fv.x * S[k] + kv.x * iv; S[k + 1] = fv.y * S[k + 1] + kv.y * iv; S[k + 2] = fv.z * S[k + 2] + kv.z * iv; S[k + 3] = fv.w * S[k + 3] + kv.w * iv;
            if (WRITE_Y) { const f32x4 qv = *(const LAS f32x4*)(bc + 128 + k); o0 += qv.x * S[k] + qv.z * S[k + 2]; o1 += qv.y * S[k + 1] + qv.w * S[k + 3]; }
        }
        if (WRITE_Y) {
            const float o = o0 + o1; const float ms = wave_sum(o * o) * (1.0f / 64.0f);
            mix[(size_t)(row0 + t) * D + 512 + ch] = f2bf_s(o * (1.0f / sqrtf(ms + EPS)) * nw * sigmoidf_(ga));
        }
        qa = qn; fa = fn; ia = in_; ga = gn; qn = qm; fn = fm; in_ = im; gn = gm;
    }
#undef HG_LOAD
}
__device__ __forceinline__ void hgrn_item(Frame& F, int l, int kind, int wi) {
#ifdef SKIP_HG
    return;
#endif
    const int lane = F.lane;
    float* sloc = (float*)(F.ws + WS_HGLOC); float* decH = (float*)(F.ws + WS_SMALL) + 1024;
    float S[64]; float decv = 1.0f;
#pragma unroll
    for (int k = 0; k < 64; ++k) S[k] = 0.f;
    if (kind == 2) {
        const int b = wi >> 2, h = wi & 3, row0 = MP + b * SL;
        ld64s(S, PIN(I_SHG) + (((size_t)l * SB + b) * 4 + h) * 4096 + lane);
        hgrn_wave<true>(F, l, h, row0, SL, S, decv);
        st64s(S, F.out + O_SHG + (((size_t)l * SB + b) * 4 + h) * 4096 + lane);
        return;
    }
    const int b = wi / 128, h = (wi / 32) % 4, c = wi % 32, row0 = b * SEQ + c * 64, sidx = (b * 4 + h) * NCH + c;
    if (kind == 0) {
        hgrn_wave<false>(F, l, h, row0, 64, S, decv);
        st64s(S, sloc + (size_t)sidx * 4096 + lane);
        decH[(size_t)sidx * 64 + lane] = decv;
        return;
    }
#pragma unroll 1
    for (int cc = 0; cc < c; ++cc) {
        const int si = (b * 4 + h) * NCH + cc; const float dv = decH[(size_t)si * 64 + lane]; const float* sp = sloc + (size_t)si * 4096 + lane;
#pragma unroll
        for (int k0 = 0; k0 < 64; k0 += 8) {
#pragma unroll
            for (int k = 0; k < 8; ++k) S[k0 + k] = S[k0 + k] * rdlane(dv, k0 + k) + sp[k * 64];
            sp += 512; OPQ(sp); }
    }
    hgrn_wave<true>(F, l, h, row0, 64, S, decv);
    if (c == NCH - 1) {
        st64s(S, F.out + O_PHG + (((size_t)l * NB + b) * 4 + h) * 4096 + lane);
    }
}

template <bool WRITE_Y>
__device__ __forceinline__ void lru_wave(Frame& F, int l, int blk, int row0, int nsteps, int hist, const float* cs  , float& hst, float& aprod) {
    const int lane = F.lane, ch = blk * 64 + lane;
    const float* cw = PIN(I_LCW) + (size_t)l * 4 * 256; const float cb = PIN(I_LCB)[l * 256 + ch];
    const float w0 = cw[ch], w1 = cw[256 + ch], w2 = cw[512 + ch], w3 = cw[768 + ch];
    const float sp = softplusf_(-PIN(I_LLAM)[l * 256 + ch]);
    const bf16* proj = PROJ(F); bf16* mix = (bf16*)(F.ws + WS_MIX);
    LAS float* bc = (LAS float*)(F.lds + WSCR_OFF) + F.wave * 256;
    LAS float* la = (LAS float*)F.lds + F.wave * 4096;
    const int last = nsteps - 1;
    float h1 = 0.f, h2 = 0.f, h3 = 0.f;
    if (hist == 1) { const bf16* p = proj + (size_t)(row0 - 1) * NPROJ + 2304 + ch; h1 = bf2f(p[0]); h2 = bf2f(p[-NPROJ]); h3 = bf2f(p[-2 * NPROJ]); }
    else if (hist == 2) { h3 = cs[ch]; h2 = cs[256 + ch]; h1 = cs[512 + ch]; }
    float wg[64];
#define LRU_LOAD(xv_, gv_, tt, GATE) do { const bf16* p_ = proj + (size_t)(row0 + ((tt) < last ? (tt) : last)) * NPROJ + ch; xv_ = bf2f(p_[2304]); gv_ = (GATE) ? bf2f(p_[2560]) : 0.f; } while (0)
    ld64s(wg, PIN(I_LWA) + ((size_t)(l * 4 + blk) * 64) * 64 + lane);
    {
        const float ba = PIN(I_LBA)[l * 256 + ch];
        float x1 = h1, x2 = h2, x3 = h3, xa, ga, xn, gn, xm, gm;
        LRU_LOAD(xa, ga, 0, false); LRU_LOAD(xn, gn, 1, false);
#pragma unroll 1
        for (int t = 0; t < nsteps; ++t) {
            LRU_LOAD(xm, gm, t + 2, false);
            const float xc = cb + w0 * x3 + w1 * x2 + w2 * x1 + w3 * xa; x3 = x2; x2 = x1; x1 = xa;
            bc[lane] = xc;
            float r0 = ba, r1 = 0.f;
#pragma unroll
            for (int k = 0; k < 64; k += 4) { const f32x4 xv = *(const LAS f32x4*)(bc + k); r0 += xv.x * wg[k] + xv.z * wg[k + 2]; r1 += xv.y * wg[k + 1] + xv.w * wg[k + 3]; }
            la[t * 64 + lane] = -8.0f * sigmoidf_(r0 + r1) * sp;
            xa = xn; xn = xm; (void)ga; (void)gn; (void)gm;
        }
    }
    ld64s(wg, PIN(I_LWX) + ((size_t)(l * 4 + blk) * 64) * 64 + lane);
    {
        const float bxx = PIN(I_LBX)[l * 256 + ch];
        float x1 = h1, x2 = h2, x3 = h3, xa, ga, xn, gn, xm, gm;
        LRU_LOAD(xa, ga, 0, WRITE_Y); LRU_LOAD(xn, gn, 1, WRITE_Y);
#pragma unroll 1
        for (int t = 0; t < nsteps; ++t) {
            LRU_LOAD(xm, gm, t + 2, WRITE_Y);
            const float xc = cb + w0 * x3 + w1 * x2 + w2 * x1 + w3 * xa; x3 = x2; x2 = x1; x1 = xa;
            bc[lane] = xc;
            float r0 = bxx, r1 = 0.f;
#pragma unroll
            for (int k = 0; k < 64; k += 4) { const f32x4 xv = *(const LAS f32x4*)(bc + k); r0 += xv.x * wg[k] + xv.z * wg[k + 2]; r1 += xv.y * wg[k + 1] + xv.w * wg[k + 3]; }
            const float ig = sigmoidf_(r0 + r1), log_a = la[t * 64 + lane];
            const float a = __expf(log_a), u = sqrtf(-expm1f(2.0f * log_a)) * (ig * xc);
            hst = a * hst + u; aprod *= a;
            if (WRITE_Y) mix[(size_t)(row0 + t) * D + 768 + ch] = f2bf_s(hst * geluf_(ga));
            xa = xn; ga = gn; xn = xm; gn = gm;
        }
    }
#undef LRU_LOAD
}
__device__ __forceinline__ void lru_item(Frame& F, int l, int kind, int wi) {
#ifdef SKIP_LRU
    return;
#endif
    const int lane = F.lane; const bf16* proj = PROJ(F);
    float* lruH = (float*)(F.ws + WS_SMALL) + 1024 + 65536; float* lruA = lruH + 65536;
    float hst = 0.f, aprod = 1.0f;
    if (kind == 2) {
        const int b = wi >> 2, blk = wi & 3, ch = blk * 64 + lane, row0 = MP + b * SL;
        hst = PIN(I_SLRU)[((size_t)l * SB + b) * 256 + ch];
        lru_wave<true>(F, l, blk, row0, SL, 2, PIN(I_SLRUC) + ((size_t)l * SB + b) * 768, hst, aprod);
        F.out[O_SLRU + ((size_t)l * SB + b) * 256 + ch] = hst;
#pragma unroll
        for (int j = 0; j < 3; ++j) F.out[O_SLRUC + ((size_t)l * SB + b) * 768 + j * 256 + ch] = bf2f(proj[(size_t)(row0 + SL - 3 + j) * NPROJ + 2304 + ch]);
        return;
    }
    const int b = wi / 128, c = (wi / 4) % 32, blk = wi % 4, ch = blk * 64 + lane, row0 = b * SEQ + c * 64;
    if (kind == 0) {
        lru_wave<false>(F, l, blk, row0, 64, c == 0 ? 0 : 1, nullptr, hst, aprod);
        lruH[(size_t)(b * NCH + c) * 256 + ch] = hst; lruA[(size_t)(b * NCH + c) * 256 + ch] = aprod;
        return;
    }
#pragma unroll 1
    for (int cc = 0; cc < c; ++cc) hst = hst * lruA[(size_t)(b * NCH + cc) * 256 + ch] + lruH[(size_t)(b * NCH + cc) * 256 + ch];
    lru_wave<true>(F, l, blk, row0, 64, c == 0 ? 0 : 1, nullptr, hst, aprod);
    if (c == NCH - 1) {
        F.out[O_PLRU + ((size_t)l * NB + b) * 256 + ch] = hst;
#pragma unroll
        for (int j = 0; j < 3; ++j) F.out[O_PLRUC + ((size_t)l * NB + b) * 768 + j * 256 + ch] = bf2f(proj[(size_t)(row0 + 61 + j) * NPROJ + 2304 + ch]);
    }
}

__device__ __forceinline__ int t5_bucket(int n) {
    if (n < 16) return n;
    const int v = 16 + (int)(__log2f((float)n * (1.0f / 16.0f)) * (16.0f / 3.0f));
    return v < 31 ? v : 31;
}
template <bool SAMPLE>
__device__ __forceinline__ void swa_item(Frame& F, int l, int it) {
#ifdef SKIP_SWA
    return;
#endif
    constexpr int NQ = SAMPLE ? 8 : 32, R = 2 * NQ, SUBS = 512 / R, NK = SAMPLE ? 136 : 160, KPS = (NK + SUBS - 1) / SUBS, OFF = SAMPLE ? 128 : 127, DPT = 64 / SUBS;
    constexpr int KS = 68, PS = 161;
    LAS float* Kl = (LAS float*)F.lds; LAS float* Vl = Kl + 160 * KS; LAS float* Pl = Vl + 160 * KS; LAS float* Bl = Pl + 64 * PS;
    const int tid = F.tid; const bf16* proj = PROJ(F);
    int b, kvh, t0, seqrow0;
    if (SAMPLE) { b = it >> 1; kvh = it & 1; t0 = 0; seqrow0 = MP + b * SL; }
    else { b = it / 128; kvh = (it / 64) & 1; t0 = (it % 64) * 32; seqrow0 = b * SEQ; }
    if (tid < 256) { const int qh = tid >> 7, df = tid & 127; Bl[tid] = PIN(I_RELB)[t5_bucket(df) * 4 + kvh * 2 + qh]; }
    for (int e = tid; e < NK * 8; e += 512) {
        const int j = e >> 3, sg = e & 7;
        f32x4 k0 = {0.f, 0.f, 0.f, 0.f}, k1 = k0, v0 = k0, v1 = k0;
        if (SAMPLE && j < 128) {
            const size_t o = ((((size_t)l * SB + b) * 128 + j) * 2 + kvh) * 64 + sg * 8;
            k0 = *(const f32x4*)(PIN(I_CK) + o); k1 = *(const f32x4*)(PIN(I_CK) + o + 4); v0 = *(const f32x4*)(PIN(I_CV) + o); v1 = *(const f32x4*)(PIN(I_CV) + o + 4);
        } else {
            const int kp = SAMPLE ? (j - 128) : (t0 - 127 + j);
            if (kp >= 0 && kp < (SAMPLE ? SL : t0 + NQ)) {
                const bf16* p = proj + (size_t)(seqrow0 + kp) * NPROJ + kvh * 64 + sg * 8;
                const v4u ku = *(const v4u*)(p + 1024), vu = *(const v4u*)(p + 1152);
                k0 = (f32x4){bflo(ku.x), bfhi(ku.x), bflo(ku.y), bfhi(ku.y)}; k1 = (f32x4){bflo(ku.z), bfhi(ku.z), bflo(ku.w), bfhi(ku.w)};
                v0 = (f32x4){bflo(vu.x), bfhi(vu.x), bflo(vu.y), bfhi(vu.y)}; v1 = (f32x4){bflo(vu.z), bfhi(vu.z), bflo(vu.w), bfhi(vu.w)};
            }
        }
        *(LAS f32x4*)(Kl + j * KS + sg * 8) = k0; *(LAS f32x4*)(Kl + j * KS + sg * 8 + 4) = k1;
        *(LAS f32x4*)(Vl + j * KS + sg * 8) = v0; *(LAS f32x4*)(Vl + j * KS + sg * 8 + 4) = v1;
    }
    const int r = tid / SUBS, sub = tid % SUBS, qh = r / NQ, tq = r % NQ, head = kvh * 2 + qh;
    const int qrow = seqrow0 + t0 + tq;
    float q[64];
    { const bf16* p = proj + (size_t)qrow * NPROJ + 768 + head * 64;
#pragma unroll
      for (int i = 0; i < 8; ++i) { const v4u u = *(const v4u*)(p + i * 8);
          q[i * 8 + 0] = bflo(u.x) * 0.125f; q[i * 8 + 1] = bfhi(u.x) * 0.125f; q[i * 8 + 2] = bflo(u.y) * 0.125f; q[i * 8 + 3] = bfhi(u.y) * 0.125f;
          q[i * 8 + 4] = bflo(u.z) * 0.125f; q[i * 8 + 5] = bfhi(u.z) * 0.125f; q[i * 8 + 6] = bflo(u.w) * 0.125f; q[i * 8 + 7] = bfhi(u.w) * 0.125f; } }
    const float sink = PIN(I_SINK)[l * 4 + head];
    __syncthreads();
    float s[KPS]; float mx = sink;
#pragma unroll
    for (int i = 0; i < KPS; ++i) {
        const int j = sub + SUBS * i; const int jj = j < NK ? j : NK - 1;
        const LAS float* kr = Kl + jj * KS;
        float a0 = 0.f, a1 = 0.f;
#pragma unroll
        for (int d = 0; d < 64; d += 4) { const f32x4 kv = *(const LAS f32x4*)(kr + d); a0 += q[d] * kv.x + q[d + 2] * kv.z; a1 += q[d + 1] * kv.y + q[d + 3] * kv.w; }
        const int df = tq + OFF - j; const int kp = SAMPLE ? 0 : (t0 - 127 + j);
        const bool valid = (j < NK) && (df >= 0) && (df < 128) && (kp >= 0);
        s[i] = valid ? (a0 + a1) + Bl[qh * 128 + (df & 127)] : -INFINITY;
        mx = fmaxf(mx, s[i]);
    }
#pragma unroll
    for (int o = 1; o < SUBS; o <<= 1) mx = fmaxf(mx, __shfl_xor(mx, o));
    float lsum = 0.f;
#pragma unroll
    for (int i = 0; i < KPS; ++i) { const int j = sub + SUBS * i; const float p = __expf(s[i] - mx); lsum += p; if (j < NK) Pl[r * PS + j] = p; }
#pragma unroll
    for (int o = 1; o < SUBS; o <<= 1) lsum += __shfl_xor(lsum, o);
    const float inv = 1.0f / (lsum + __expf(sink - mx));
    __syncthreads();
    float acc[DPT];
#pragma unroll
    for (int d = 0; d < DPT; ++d) acc[d] = 0.f;
    for (int j = 0; j < NK; ++j) {
        const float p = Pl[r * PS + j]; const LAS float* vr = Vl + j * KS + sub * DPT;
#pragma unroll
        for (int d = 0; d < DPT; ++d) acc[d] += p * vr[d];
    }
    bf16* mo = (bf16*)(F.ws + WS_MIX) + (size_t)qrow * D + 256 + head * 64 + sub * DPT;
#pragma unroll
    for (int d = 0; d < DPT; d += 2) *(unsigned*)(mo + d) = pk2(acc[d] * inv, acc[d + 1] * inv);
    if (SAMPLE) {
        for (int e = tid; e < 128 * 16; e += 512) { const int w = e >> 4, sg = e & 15, j = w + 8;
            const size_t o = ((((size_t)l * SB + b) * 128 + w) * 2 + kvh) * 64 + sg * 4;
            *(f32x4*)(F.out + O_SK + o) = *(const LAS f32x4*)(Kl + j * KS + sg * 4); *(f32x4*)(F.out + O_SV + o) = *(const LAS f32x4*)(Vl + j * KS + sg * 4); }
    } else if (t0 == SEQ - 32) {
        for (int e = tid; e < 128 * 16; e += 512) { const int w = e >> 4, sg = e & 15, j = w + 31;
            const size_t o = ((((size_t)l * NB + b) * 128 + w) * 2 + kvh) * 64 + sg * 4;
            *(f32x4*)(F.out + O_PK + o) = *(const LAS f32x4*)(Kl + j * KS + sg * 4); *(f32x4*)(F.out + O_PV + o) = *(const LAS f32x4*)(Vl + j * KS + sg * 4); }
    }
    __syncthreads();
}

template <class T> __device__ __forceinline__ T* launder_ptr(T* p) {
    unsigned long long v = (unsigned long long)p; unsigned lo = (unsigned)v, hi = (unsigned)(v >> 32);
    asm volatile("" : "+v"(lo), "+v"(hi));
    lo = (unsigned)__builtin_amdgcn_readfirstlane((int)lo); hi = (unsigned)__builtin_amdgcn_readfirstlane((int)hi);
    return (T*)(GAS T*)(((unsigned long long)hi << 32) | lo);
}
#define OPAQUE_TID(Fx) do { int t_ = (Fx).tid; asm volatile("" : "+v"(t_)); (Fx).tid = t_; (Fx).lane = t_ & 63; } while (0)
constexpr int M1_SSD = 0, M1_HG = 128, M1_LRU = 256, M1_SSSD = 384, M1_SHG = 448, M1_SLRU = 512, M1_SSWA = 576, M1_END = 832;
constexpr int M2_SSD = 0, M2_HG = 128, M2_LRU = 256, M2_SWA = 384, M2_END = 1408;
__device__ __forceinline__ int queue_next(Frame& F, int q) {
    __syncthreads();
    if (F.tid == 0) F.MISC[16] = __hip_atomic_fetch_add((unsigned*)(F.ctl + CW_QUEUE + 64 * q), 1u, __ATOMIC_RELAXED, __HIP_MEMORY_SCOPE_AGENT);
    __syncthreads();
    return (int)F.MISC[16];
}
__device__ __forceinline__ void mixer_phase1(Frame& F0, int l) {
    for (;;) {
        const int it = queue_next(F0, 2 * l);
        if (it >= M1_END) break;
        Frame F = F0; OPAQUE_TID(F);
        if (it < M1_HG) ssd_item(F, l, 0, it);
        else if (it < M1_LRU) hgrn_item(F, l, 0, (it - M1_HG) * 8 + F.wave);
        else if (it < M1_SSSD) lru_item(F, l, 0, (it - M1_LRU) * 8 + F.wave);
        else if (it < M1_SHG) ssd_item(F, l, 2, it - M1_SSSD);
        else if (it < M1_SLRU) hgrn_item(F, l, 2, (it - M1_SHG) * 8 + F.wave);
        else if (it < M1_SSWA) lru_item(F, l, 2, (it - M1_SLRU) * 8 + F.wave);
        else swa_item<true>(F, l, it - M1_SSWA);
    }
}
__device__ __forceinline__ void mixer_phase2(Frame& F0, int l) {
    for (;;) {
        const int it = queue_next(F0, 2 * l + 1);
        if (it >= M2_END) break;
        Frame F = F0; OPAQUE_TID(F);
        if (it < M2_HG) ssd_item(F, l, 1, it);
        else if (it < M2_LRU) hgrn_item(F, l, 1, (it - M2_HG) * 8 + F.wave);
        else if (it < M2_SWA) lru_item(F, l, 1, (it - M2_LRU) * 8 + F.wave);
        else swa_item<false>(F, l, it - M2_SWA);
    }
}

struct Args { const float* in[33]; float* out; unsigned char* ws; int ph_lo, ph_hi, li, pad; };
constexpr int N_PHASES = 1 + 2 * 6 + 1;
template <int KIND> __global__ void __launch_bounds__(NWAVES * 64, 2) mk_fwd(Args args) {
#define KON(k) (KIND == 0 || KIND == (k))
    extern __shared__ __attribute__((aligned(16))) unsigned char lds[];
    Frame F;
    F.lds = (LAS unsigned char*)lds;
    F.MISC = (volatile LAS unsigned*)(F.lds + MISC_OFF);
    F.tid = threadIdx.x; F.lane = F.tid & 63; F.wave = __builtin_amdgcn_readfirstlane(F.tid >> 6);
    F.G = gridDim.x; { const int bx = blockIdx.x; F.vcu = (F.G % 8 == 0) ? (bx % 8) * (F.G / 8) + bx / 8 : bx; }
    F.in = args.in;
    F.out = args.out; F.ws = args.ws; F.ctl = (gu32*)(args.ws + WS_CTL);
    for (int u = F.tid; u < (LDS_BYTES - LDSCTL_OFF) / 4; u += NWAVES * 64) ((LAS unsigned*)(F.lds + LDSCTL_OFF))[u] = 0u;
    __syncthreads();
    XcdBarrier bar; bar.bar = (unsigned*)(F.ctl + CW_BAR); bar.x = 0; bar.st = nullptr;
    if (!MK_PER_PHASE) bar = xcd_barrier_post((unsigned*)(F.ctl + CW_BAR), F.MISC + 8);
    const int lo = args.ph_lo, hi = args.ph_hi;
#define IN(k) (lo <= (k) && (k) < hi)
#define SEAM(k) do { if (IN(k) && IN((k) + 1)) xcd_barrier(bar); } while (0)
#define PHASE_FRAME() Frame Fm = F; OPAQUE_TID(Fm);
#define WSP(T, off) ((T*)(F.ws + (off)))
    if constexpr (KON(1)) if (IN(0)) { PHASE_FRAME(); p0_prologue(Fm); }
    SEAM(0);
#pragma unroll
    for (int l = 0; l < 2; ++l) {
        const int pb = 1 + 6 * l;
        if constexpr (KON(2)) if (IN(pb)) {
            pg8::Gemm g{WSP(bf16, WS_XB), WSP(bf16, WS_WIN) + (size_t)l * NPROJ * D, M, NPROJ, D}; pg8::StaticOrder S; S.init(M, NPROJ, F.G, (int)blockIdx.x);
            pg8::EpiScaleBf16<0> E{WSP(bf16, WS_PROJ), NPROJ, WSP(float, WS_SSQA)};
            pg8::gemm_phase<pg8::EpiScaleBf16<0>, pg8::StaticOrder, true, true>(F.lds, g, S, E);
        }
        SEAM(pb);
#ifndef SKIP_M1
        if constexpr (KON(3)) if (IN(pb + 1)) { PHASE_FRAME(); mixer_phase1(Fm, l); }
#endif
        SEAM(pb + 1);
#ifndef SKIP_M2
        if constexpr (KON(4)) if (IN(pb + 2)) { PHASE_FRAME(); mixer_phase2(Fm, l); }
#endif
        SEAM(pb + 2);
        if constexpr (KON(5)) if (IN(pb + 3)) {
            pg8::Gemm g{WSP(bf16, WS_MIX), WSP(bf16, WS_WOUT) + (size_t)l * D * D, M, D, D}; pg8::StaticOrder S; S.init(M, D, F.G, (int)blockIdx.x);
            pg8::EpiResidual E{l == 0 ? F.in[I_XP] : F.out, l == 0 ? F.in[I_XS] : F.out + (size_t)MP * D, MP, F.out, WSP(bf16, WS_XB), WSP(float, WS_SSQB)};
            pg8::gemm_phase<pg8::EpiResidual, pg8::StaticOrder, true, true>(F.lds, g, S, E);
        }
        SEAM(pb + 3);
        if constexpr (KON(6)) if (IN(pb + 4)) {
            pg8::Gemm g{WSP(bf16, WS_XB), WSP(bf16, WS_WUP) + (size_t)l * FF * D, M, FF, D}; pg8::StaticOrder S; S.init(M, FF, F.G, (int)blockIdx.x);
            pg8::EpiScaleBf16<1> E{WSP(bf16, WS_UP), FF, WSP(float, WS_SSQB)};
            pg8::gemm_phase<pg8::EpiScaleBf16<1>, pg8::StaticOrder, true, true>(F.lds, g, S, E);
        }
        SEAM(pb + 4);
        if constexpr (KON(7)) if (IN(pb + 5)) {
            pg8::Gemm g{WSP(bf16, WS_UP), WSP(bf16, WS_WDN) + (size_t)l * D * FF, M, D, FF}; pg8::StaticOrder S; S.init(M, D, F.G, (int)blockIdx.x);
            pg8::EpiResidual E{F.out, F.out + (size_t)MP * D, MP, F.out, WSP(bf16, WS_XB), WSP(float, WS_SSQA)};
            pg8::gemm_phase<pg8::EpiResidual, pg8::StaticOrder, true, true>(F.lds, g, S, E);
        }
        SEAM(pb + 5);
    }
    if constexpr (KON(8)) if (IN(N_PHASES - 1)) { PHASE_FRAME(); final_norm(Fm); }
#undef IN
#undef SEAM
}

template <int KIND> static void launch_kind(const Args& a, int grid, hipStream_t stream) {
    static bool attr_set = false;
    if (!attr_set) { (void)hipFuncSetAttribute((const void*)mk_fwd<KIND>, hipFuncAttributeMaxDynamicSharedMemorySize, LDS_BYTES); attr_set = true; }
    hipLaunchKernelGGL(mk_fwd<KIND>, dim3(grid), dim3(NWAVES * 64), LDS_BYTES, stream, a);
}
extern "C" void kernel_launch(void* const* d_in, const int* in_sizes, int n_in, void* d_out, int out_size, void* d_ws, size_t ws_size, hipStream_t stream) {
    static int grid = 0;
    if (grid == 0) {
        if (n_in != 33 || out_size != (int)O_END || ws_size < WS_END) { fprintf(stderr, "kernel_launch: unexpected shapes n_in %d out %d ws %zu\n", n_in, out_size, ws_size); grid = -1; return; }
        int dev = 0, cus = 0;
        if (hipGetDevice(&dev) != hipSuccess || hipDeviceGetAttribute(&cus, hipDeviceAttributeMultiprocessorCount, dev) != hipSuccess) { grid = -1; return; }
        grid = cus;
    }
    if (grid < 0) return;
    (void)hipMemsetAsync((char*)d_ws + WS_CTL, 0, CTL_ZERO_BYTES, stream);
    Args a{};
    for (int i = 0; i < 33; ++i) a.in[i] = (const float*)d_in[i];
    a.out = (float*)d_out; a.ws = (unsigned char*)d_ws;
#if MK_PER_PHASE
    for (int p = 0; p < N_PHASES; ++p) {
        a.ph_lo = p; a.ph_hi = p + 1; a.li = p;
        if (p == 0) launch_kind<1>(a, grid, stream);
        else if (p == N_PHASES - 1) launch_kind<8>(a, grid, stream);
        else switch ((p - 1) % 6) {
            case 0: launch_kind<2>(a, grid, stream); break; case 1: launch_kind<3>(a, grid, stream); break; case 2: launch_kind<4>(a, grid, stream); break;
            case 3: launch_kind<5>(a, grid, stream); break; case 4: launch_kind<6>(a, grid, stream); break; default: launch_kind<7>(a, grid, stream); break; }
    }
#else
    a.ph_lo = 0; a.ph_hi = N_PHASES; a.li = 0;
    launch_kind<0>(a, grid, stream);
#endif
}
```

```cpp
#include <hip/hip_runtime.h>
#include <cstdio>
#include <cstdint>
#include <cmath>
namespace pg8 {
#define PG8_LAS __attribute__((address_space(3)))
typedef unsigned short bf16_t;
typedef short bf16x8 __attribute__((ext_vector_type(8)));
typedef float f32x4 __attribute__((ext_vector_type(4)));
typedef unsigned u32x4 __attribute__((ext_vector_type(4)));
constexpr int BM = 256, BK = 64, HALF = 128, HTB = HALF * BK * 2  , STAGE_BYTES = 8 * HTB, NXCD = 8, WGM = 8;

__host__ __device__ __forceinline__ int lds_byte(int r, int c) { const int st = (r >> 4) * 2 + (c >> 5), rr = r & 15, cc = c & 31, ob = rr * 64 + cc * 2; return st * 1024 + (ob ^ (((ob >> 9) & 1) << 5)); }
__host__ __device__ __forceinline__ void stage_rc(int b, int& R, int& C) { const int st = b / 1024, sb = b % 1024, swz = sb ^ (((sb >> 9) & 1) << 5); R = (st >> 1) * 16 + swz / 64; C = (st & 1) * 32 + (swz % 64) / 2; }
__host__ __device__ __forceinline__ int perm32(int rho) { const int n = rho >> 4, i = rho & 15; return 8 * (i >> 2) + 4 * n + (i & 3); }

struct Unit { int pm, pn, kp; };
struct Gemm { const bf16_t* A; const bf16_t* Bt; int M, N, K; int ld; int kpb; };

struct StaticOrder {
    int nM, nN, nwg, G, c;
    __host__ __device__ void init(int M, int N, int G_, int c_) { nM = M / BM; nN = N / BM; nwg = nM * nN; G = G_; c = c_; }
    __host__ __device__ bool next(int i, Unit& u) const {
        const long L = (long)i * G + c; if (L >= nwg) return false;
        int wgid = (int)L; { const int q = nwg / NXCD, r = nwg % NXCD, xcd = wgid % NXCD, off = wgid / NXCD; wgid = (xcd < r ? xcd * (q + 1) : r * (q + 1) + (xcd - r) * q) + off; }
        const int nig = WGM * nN, gid = wgid / nig, fm = gid * WGM, gsz = (nM - fm) < WGM ? (nM - fm) : WGM;
        u.pm = fm + ((wgid % nig) % gsz); u.pn = (wgid % nig) / gsz; u.kp = 0; return true;
    }
    __device__ __forceinline__ void a_ready(const Unit&) const {}
    __device__ __forceinline__ void done(const Unit&) const {}
};
__device__ __forceinline__ unsigned cvt_pk_bf16(float lo, float hi) { unsigned r; asm volatile("v_cvt_pk_bf16_f32 %0, %1, %2" : "=v"(r) : "v"(lo), "v"(hi)); return r; }
typedef float f32x2 __attribute__((ext_vector_type(2)));
__device__ __forceinline__ float xsum4(const f32x4 v) { return (v[0] + v[1]) + (v[2] + v[3]); }
template <int ACT> struct EpiScaleBf16 {
    static constexpr bool PERM = true, AFTER_DRAIN = false;
    bf16_t* O; int ldc; const float* ssq; unsigned obytes;
    __device__ __forceinline__ void operator()(const f32x4 (&acc)[2][2][4][2], const Unit& u, int wr, int wc, int fr, int fq) const {
        const __amdgpu_buffer_rsrc_t orsrc = __builtin_amdgcn_make_buffer_rsrc((void*)O, 0, (int)obytes, 0x00020000);
        const int row0 = u.pm * BM + wr * 64 + fr, col0 = u.pn * BM + wc * 32 + 8 * fq;
        f32x4 pvs[2][4];
#pragma unroll
        for (int ai = 0; ai < 2; ++ai)
#pragma unroll
            for (int m = 0; m < 4; ++m) pvs[ai][m] = *(const f32x4*)(ssq + (size_t)(row0 + ai * HALF + m * 16) * 16 + 4 * fq);
#pragma unroll
        for (int ai = 0; ai < 2; ++ai)
#pragma unroll
            for (int m = 0; m < 4; ++m) {
                const int row = row0 + ai * HALF + m * 16;
                const f32x4 pv = pvs[ai][m];
                float s = xsum4(pv); s += __shfl_xor(s, 16); s += __shfl_xor(s, 32);
                const float rs = 1.0f / sqrtf(s * (1.0f / 1024.0f) + 1e-6f);
                bf16_t* rowp = O + (size_t)row * ldc + col0;
#pragma unroll
                for (int bj = 0; bj < 2; ++bj) {
                    f32x4 v0 = acc[ai][bj][m][0] * rs, v1 = acc[ai][bj][m][1] * rs;
                    if (ACT == 1) {
#pragma unroll
                        for (int e = 0; e < 4; ++e) { const float a = fmaxf(v0[e], 0.f), b = fmaxf(v1[e], 0.f); v0[e] = a * a; v1[e] = b * b; }
                    }
                    u32x4 w; w.x = cvt_pk_bf16(v0[0], v0[1]); w.y = cvt_pk_bf16(v0[2], v0[3]); w.z = cvt_pk_bf16(v1[0], v1[1]); w.w = cvt_pk_bf16(v1[2], v1[3]);
                    __builtin_amdgcn_raw_buffer_store_b128(w, orsrc, (unsigned)(((size_t)row * ldc + col0 + bj * HALF) * 2), 0, 16);
                }
            }
    }
};
struct EpiResidual {
    static constexpr bool PERM = false, AFTER_DRAIN = false;
    const float* xin_p; const float* xin_s; int split_row;
    float* Xout; bf16_t* xb; float* ssq;
    __device__ __forceinline__ void operator()(const f32x4 (&acc)[2][2][4][2], const Unit& u, int wr, int wc, int fr, int fq) const {
        typedef unsigned u32x2v __attribute__((ext_vector_type(2)));
        const int col0 = u.pn * BM + wc * 32 + 4 * fq;
#pragma unroll
        for (int ai = 0; ai < 2; ++ai)
#pragma unroll
            for (int m = 0; m < 4; ++m) {
                const int row = u.pm * BM + ai * HALF + wr * 64 + m * 16 + fr;
                const float* src = (row < split_row) ? xin_p + (size_t)row * 1024 : xin_s + (size_t)(row - split_row) * 1024;
                float q = 0.f;
#pragma unroll
                for (int bj = 0; bj < 2; ++bj)
#pragma unroll
                    for (int n = 0; n < 2; ++n) {
                        const int off = col0 + bj * HALF + n * 16;
                        const f32x4 o = *(const f32x4*)(src + off) + acc[ai][bj][m][n];
                        *(f32x4*)(Xout + (size_t)row * 1024 + off) = o;
                        u32x2v w; w.x = cvt_pk_bf16(o[0], o[1]); w.y = cvt_pk_bf16(o[2], o[3]);
                        *(u32x2v*)(xb + (size_t)row * 1024 + off) = w;
                        q += (o[0] * o[0] + o[1] * o[1]) + (o[2] * o[2] + o[3] * o[3]);
                    }
                q += __shfl_xor(q, 16); q += __shfl_xor(q, 32);
                if (fq == 0) ssq[(size_t)row * 16 + u.pn * 4 + wc] = q;
            }
    }
};
struct EpiPartial {
    static constexpr bool PERM = true, AFTER_DRAIN = false;
    bf16_t* slab; int pm0, kparts;
    __device__ __forceinline__ void operator()(const f32x4 (&acc)[2][2][4][2], const Unit& u, int wr, int wc, int fr, int fq) const {
        bf16_t* base = slab + (size_t)(((u.pm - pm0) * 4 + u.pn) * kparts + u.kp) * 65536;
        const int col0 = wc * 32 + 8 * fq;
#pragma unroll
        for (int ai = 0; ai < 2; ++ai)
#pragma unroll
            for (int m = 0; m < 4; ++m) {
                const int row = ai * HALF + wr * 64 + m * 16 + fr;
#pragma unroll
                for (int bj = 0; bj < 2; ++bj) { const f32x4 v0 = acc[ai][bj][m][0], v1 = acc[ai][bj][m][1];
                    u32x4 w; w.x = cvt_pk_bf16(v0[0], v0[1]); w.y = cvt_pk_bf16(v0[2], v0[3]); w.z = cvt_pk_bf16(v1[0], v1[1]); w.w = cvt_pk_bf16(v1[2], v1[3]);
                    *(u32x4*)(base + row * 256 + col0 + bj * HALF) = w; }
            }
    }
};
struct SplitOrder {
    int G, c, pm0, kparts;
    __device__ bool next(int i, Unit& u) const { const int L = i * G + c; if (L >= 16 * kparts) return false; const int tile = L / kparts; u.kp = L % kparts; u.pm = pm0 + tile / 4; u.pn = tile % 4; return true; }
    __device__ __forceinline__ void a_ready(const Unit&) const {}
    __device__ __forceinline__ void done(const Unit&) const {}
};
struct OneUnit {
    int pm, pn, kp;
    __device__ bool next(int i, Unit& u) const { if (i) return false; u.pm = pm; u.pn = pn; u.kp = kp; return true; }
    __device__ __forceinline__ void a_ready(const Unit&) const {}
    __device__ __forceinline__ void done(const Unit&) const {}
};
struct EpiResidualB {
    static constexpr bool PERM = true, AFTER_DRAIN = false;
    bf16_t* xb; float* ssq;
    __device__ __forceinline__ void operator()(const f32x4 (&acc)[2][2][4][2], const Unit& u, int wr, int wc, int fr, int fq) const {
        const int row0 = u.pm * BM + wr * 64 + fr, col0 = u.pn * BM + wc * 32 + 8 * fq;
        u32x4 rv[2][4][2];
#pragma unroll
        for (int ai = 0; ai < 2; ++ai)
#pragma unroll
            for (int m = 0; m < 4; ++m)
#pragma unroll
                for (int bj = 0; bj < 2; ++bj) rv[ai][m][bj] = *(const u32x4*)(xb + (size_t)(row0 + ai * HALF + m * 16) * 1024 + col0 + bj * HALF);
#pragma unroll
        for (int ai = 0; ai < 2; ++ai)
#pragma unroll
            for (int m = 0; m < 4; ++m) {
                const int row = row0 + ai * HALF + m * 16;
                bf16_t* rowp = xb + (size_t)row * 1024 + col0;
                float q = 0.f;
#pragma unroll
                for (int bj = 0; bj < 2; ++bj) {
                    const u32x4 r = rv[ai][m][bj];
                    const f32x4 v0 = acc[ai][bj][m][0] + (f32x4){__builtin_bit_cast(float, r.x << 16), __builtin_bit_cast(float, r.x & 0xffff0000u), __builtin_bit_cast(float, r.y << 16), __builtin_bit_cast(float, r.y & 0xffff0000u)};
                    const f32x4 v1 = acc[ai][bj][m][1] + (f32x4){__builtin_bit_cast(float, r.z << 16), __builtin_bit_cast(float, r.z & 0xffff0000u), __builtin_bit_cast(float, r.w << 16), __builtin_bit_cast(float, r.w & 0xffff0000u)};
                    q += ((v0[0] * v0[0] + v0[1] * v0[1]) + (v0[2] * v0[2] + v0[3] * v0[3])) + ((v1[0] * v1[0] + v1[1] * v1[1]) + (v1[2] * v1[2] + v1[3] * v1[3]));
                    u32x4 w; w.x = cvt_pk_bf16(v0[0], v0[1]); w.y = cvt_pk_bf16(v0[2], v0[3]); w.z = cvt_pk_bf16(v1[0], v1[1]); w.w = cvt_pk_bf16(v1[2], v1[3]);
                    *(u32x4*)(rowp + bj * HALF) = w;
                }
                q += __shfl_xor(q, 16); q += __shfl_xor(q, 32);
                if (fq == 0) ssq[(size_t)row * 16 + u.pn * 4 + wc] = q;
            }
    }
};
template <class Epi, class Sched, bool ALIGN_EPI = false, bool SP2 = false>
__device__ __forceinline__ void gemm_phase(PG8_LAS unsigned char* lds, const Gemm g, const Sched& S, const Epi& E) {
    int tid_ = threadIdx.x; asm volatile("" : "+v"(tid_));
    const int tid = tid_, wid = __builtin_amdgcn_readfirstlane(tid >> 6), lane = tid & 63, wr = wid >> 2, wc = wid & 3, fr = lane & 15, fq = lane >> 4;
    const int K = g.K, nt = K / BK, LD = g.ld ? g.ld : g.K;
    unsigned voffA[2], voffB[2];
#pragma unroll
    for (int i = 0; i < 2; ++i) { int R, C; stage_rc(tid * 16 + i * 8192, R, C); const int Rb = Epi::PERM ? ((R & ~31) + perm32(R & 31)) : R;
        voffA[i] = (unsigned)(R * LD + C) * 2u; voffB[i] = (unsigned)(Rb * LD + C) * 2u; }
    const size_t kstep = (size_t)(BK * 2);
    const size_t hstep = (size_t)HALF * LD * 2;
    const size_t tstep = 2 * hstep;
    const unsigned ldsw = (unsigned)wid * 1024u;
    const int aoff = lds_byte(wr * 64 + fr, fq * 8), boff = lds_byte(wc * 32 + fr, fq * 8);
#define PG8_SA(b, h) (((b) * 2 + (h)) * HTB)
#define PG8_SB(b, h) ((4 + (b) * 2 + (h)) * HTB)
#define PG8_STAGE(bufoff, gbase, voff) do { _Pragma("unroll") for (int _i = 0; _i < 2; ++_i) \
        __builtin_amdgcn_global_load_lds((const unsigned*)((const char*)(gbase) + (voff)[_i]), (PG8_LAS unsigned*)(lds + (bufoff) + ldsw + _i * 8192), 16, 0, 0); } while (0)
#define PG8_LDA(dst, b, h) do { _Pragma("unroll") for (int m = 0; m < 4; ++m) _Pragma("unroll") for (int k = 0; k < 2; ++k) dst[m][k] = *(const PG8_LAS bf16x8*)(lds + PG8_SA(b, h) + aoff + m * 2048 + k * 1024); } while (0)
#define PG8_LDB(dst, b, h) do { _Pragma("unroll") for (int n = 0; n < 2; ++n) _Pragma("unroll") for (int k = 0; k < 2; ++k) dst[n][k] = *(const PG8_LAS bf16x8*)(lds + PG8_SB(b, h) + boff + n * 2048 + k * 1024); } while (0)
#define PG8_MMA(ai, bj, At, Bt) do { __builtin_amdgcn_s_setprio(1); _Pragma("unroll") for (int m = 0; m < 4; ++m) _Pragma("unroll") for (int n = 0; n < 2; ++n) _Pragma("unroll") for (int k = 0; k < 2; ++k) \
        acc[ai][bj][m][n] = __builtin_amdgcn_mfma_f32_16x16x32_bf16(Bt[n][k], At[m][k], acc[ai][bj][m][n], 0, 0, 0); __builtin_amdgcn_s_setprio(0); } while (0)
#define PG8_WAIT_V(n) asm volatile("s_waitcnt vmcnt(" #n ")" ::: "memory")
#define PG8_WAIT_L(n) asm volatile("s_waitcnt lgkmcnt(" #n ")" ::: "memory")
#define PG8_BAR __builtin_amdgcn_s_barrier()
#define PG8_SCHED __builtin_amdgcn_sched_barrier(0)
    Unit cur, nxt; int ui = 0;
    if (!S.next(0, cur)) return;
    f32x4 acc[2][2][4][2];
#pragma unroll
    for (int a = 0; a < 2; ++a)
#pragma unroll
        for (int b = 0; b < 2; ++b)
#pragma unroll
            for (int m = 0; m < 4; ++m)
#pragma unroll
                for (int n = 0; n < 2; ++n) acc[a][b][m][n] = (f32x4){0.f, 0.f, 0.f, 0.f};
    bf16x8 At[4][2], B0[2][2], B1[2][2];
    const char* cA = (const char*)g.A + (size_t)cur.pm * tstep + (size_t)cur.kp * g.kpb; const char* cB = (const char*)g.Bt + (size_t)cur.pn * tstep + (size_t)cur.kp * g.kpb;
    S.a_ready(cur);
    if constexpr (SP2) {
        PG8_STAGE(PG8_SB(0, 0), cB, voffB); PG8_STAGE(PG8_SB(0, 1), cB + hstep, voffB); PG8_STAGE(PG8_SA(0, 0), cA, voffA); PG8_STAGE(PG8_SA(0, 1), cA + hstep, voffA);
        if (wr == 1) PG8_BAR;
        PG8_WAIT_V(2); PG8_BAR;
        PG8_STAGE(PG8_SB(1, 0), cB + kstep, voffB); PG8_STAGE(PG8_SA(1, 0), cA + kstep, voffA); PG8_STAGE(PG8_SB(1, 1), cB + hstep + kstep, voffB);
        PG8_WAIT_V(6); PG8_BAR;
    } else {
        PG8_STAGE(PG8_SB(0, 0), cB, voffB); PG8_STAGE(PG8_SA(0, 0), cA, voffA); PG8_STAGE(PG8_SB(0, 1), cB + hstep, voffB); PG8_STAGE(PG8_SA(0, 1), cA + hstep, voffA);
        if (wr == 1) PG8_BAR;
        PG8_WAIT_V(4); PG8_BAR;
        PG8_STAGE(PG8_SB(1, 0), cB + kstep, voffB); PG8_STAGE(PG8_SA(1, 0), cA + kstep, voffA); PG8_STAGE(PG8_SB(1, 1), cB + hstep + kstep, voffB);
        PG8_WAIT_V(6); PG8_BAR;
    }
    for (;;) {
        const bool has_next = S.next(ui + 1, nxt);
        const char* nA = has_next ? (const char*)g.A + (size_t)nxt.pm * tstep + (size_t)nxt.kp * g.kpb : cA; const char* nB = has_next ? (const char*)g.Bt + (size_t)nxt.pn * tstep + (size_t)nxt.kp * g.kpb : cB;
        for (int t = 0; t < nt; t += 2) {
            const bool last = (t == nt - 2);
            const char* a1 = cA + (size_t)(t + 1) * kstep;
            const char* a2 = last ? nA : cA + (size_t)(t + 2) * kstep; const char* b2 = last ? nB : cB + (size_t)(t + 2) * kstep;
            const char* a3 = a2 + kstep; const char* b3 = b2 + kstep;
            if (last && has_next) S.a_ready(nxt);
            if constexpr (SP2) {
            PG8_LDB(B0, 0, 0); PG8_LDB(B1, 0, 1); PG8_SCHED; PG8_LDA(At, 0, 0); PG8_STAGE(PG8_SA(1, 1), a1 + hstep, voffA);
            PG8_WAIT_V(8); PG8_WAIT_L(0); PG8_BAR; PG8_MMA(0, 0, At, B0); PG8_MMA(0, 1, At, B1); PG8_BAR; PG8_SCHED;
            PG8_LDA(At, 0, 1); PG8_STAGE(PG8_SB(0, 0), b2, voffB); PG8_STAGE(PG8_SB(0, 1), b2 + hstep, voffB); PG8_STAGE(PG8_SA(0, 0), a2, voffA);
            PG8_WAIT_V(8); PG8_WAIT_L(0); PG8_BAR; PG8_MMA(1, 0, At, B0); PG8_MMA(1, 1, At, B1); PG8_BAR; PG8_SCHED;
            PG8_LDB(B0, 1, 0); PG8_LDB(B1, 1, 1); PG8_SCHED; PG8_LDA(At, 1, 0); PG8_STAGE(PG8_SA(0, 1), a2 + hstep, voffA);
            PG8_WAIT_V(8); PG8_WAIT_L(0); PG8_BAR; PG8_MMA(0, 0, At, B0); PG8_MMA(0, 1, At, B1); PG8_BAR; PG8_SCHED;
            PG8_LDA(At, 1, 1); PG8_STAGE(PG8_SB(1, 0), b3, voffB); PG8_STAGE(PG8_SB(1, 1), b3 + hstep, voffB); PG8_STAGE(PG8_SA(1, 0), a3, voffA);
            PG8_WAIT_V(8); PG8_WAIT_L(0); PG8_BAR; PG8_MMA(1, 0, At, B0); PG8_MMA(1, 1, At, B1); PG8_BAR; PG8_SCHED;
            } else {
            PG8_LDB(B0, 0, 0); PG8_SCHED; PG8_LDA(At, 0, 0); PG8_STAGE(PG8_SA(1, 1), a1 + hstep, voffA);
            PG8_WAIT_L(8); PG8_BAR; PG8_WAIT_L(0); PG8_MMA(0, 0, At, B0); PG8_BAR; PG8_SCHED;
            PG8_LDB(B1, 0, 1); PG8_STAGE(PG8_SB(0, 0), b2, voffB);
            PG8_BAR; PG8_WAIT_L(0); PG8_MMA(0, 1, At, B1); PG8_BAR;
            PG8_LDA(At, 0, 1); PG8_STAGE(PG8_SA(0, 0), a2, voffA);
            PG8_BAR; PG8_WAIT_L(0); PG8_MMA(1, 0, At, B0); PG8_BAR; PG8_SCHED;
            PG8_STAGE(PG8_SB(0, 1), b2 + hstep, voffB);
            PG8_WAIT_V(6); PG8_BAR; PG8_MMA(1, 1, At, B1); PG8_BAR;
            PG8_LDB(B0, 1, 0); PG8_SCHED; PG8_LDA(At, 1, 0); PG8_STAGE(PG8_SA(0, 1), a2 + hstep, voffA);
            PG8_WAIT_L(8); PG8_BAR; PG8_WAIT_L(0); PG8_MMA(0, 0, At, B0); PG8_BAR; PG8_SCHED;
            PG8_LDB(B1, 1, 1); PG8_STAGE(PG8_SB(1, 0), b3, voffB);
            PG8_BAR; PG8_WAIT_L(0); PG8_MMA(0, 1, At, B1); PG8_BAR;
            PG8_LDA(At, 1, 1); PG8_STAGE(PG8_SA(1, 0), a3, voffA);
            PG8_BAR; PG8_WAIT_L(0); PG8_MMA(1, 0, At, B0); PG8_BAR; PG8_SCHED;
            PG8_STAGE(PG8_SB(1, 1), b3 + hstep, voffB);
            PG8_WAIT_V(6); PG8_BAR; PG8_MMA(1, 1, At, B1); PG8_BAR;
            }
        }
        if constexpr (ALIGN_EPI) { if (wr == 0) PG8_BAR; }
        if constexpr (!Epi::AFTER_DRAIN) { E(acc, cur, wr, wc, fr, fq); S.done(cur); }
        if (!has_next) break;
#pragma unroll
        for (int a = 0; a < 2; ++a)
#pragma unroll
            for (int b = 0; b < 2; ++b)
#pragma unroll
                for (int m = 0; m < 4; ++m)
#pragma unroll
                    for (int n = 0; n < 2; ++n) acc[a][b][m][n] = (f32x4){0.f, 0.f, 0.f, 0.f};
        cur = nxt; cA = nA; cB = nB; ++ui;
        if constexpr (ALIGN_EPI) { if (wr == 1) PG8_BAR; }
    }
    PG8_WAIT_V(0);
    if constexpr (!ALIGN_EPI) { if (wr == 0) PG8_BAR; }
    PG8_BAR;
    if constexpr (Epi::AFTER_DRAIN) { E.fused(acc, cur, wr, wc, fr, fq, lds, wid, lane); S.done(cur); }
#undef PG8_SA
#undef PG8_SB
#undef PG8_STAGE
#undef PG8_LDA
#undef PG8_LDB
#undef PG8_MMA
#undef PG8_WAIT_V
#undef PG8_WAIT_L
#undef PG8_BAR
#undef PG8_SCHED
}
}
#define GAS __attribute__((address_space(1)))
#define LAS __attribute__((address_space(3)))
typedef unsigned short bf16;
typedef unsigned v4u __attribute__((ext_vector_type(4)));
typedef float f32x4 __attribute__((ext_vector_type(4)));
typedef short bf16x8 __attribute__((ext_vector_type(8)));
typedef GAS unsigned gu32;
typedef GAS unsigned long long gu64;
#define RLX_AGENT __ATOMIC_RELAXED, __HIP_MEMORY_SCOPE_AGENT
#define LDS_WAIT() asm volatile("s_waitcnt lgkmcnt(0)" ::: "memory")
#define VM_WAIT() asm volatile("s_waitcnt vmcnt(0)" ::: "memory")
__device__ __forceinline__ unsigned long long rt() { return __builtin_amdgcn_s_memrealtime(); }
__device__ __forceinline__ unsigned f2bf(float f) { unsigned u = __builtin_bit_cast(unsigned, f); return (u + 0x7fffu + ((u >> 16) & 1u)) >> 16; }
__device__ __forceinline__ unsigned pk2(float lo, float hi) { return f2bf(lo) | (f2bf(hi) << 16); }

#define XB_TMO      128
#define XB_XCNT(j)  (256  + 64 * (j))
#define XB_XSUB(j)  (1280 + 64 * (j))
#define XB_XGEN(j)  (2304 + 64 * (j))
#define XB_TOP      3328
#define XB_TOPGEN   3392
#define XCD_BAR_WORDS 3456
#define XB_SPIN_CAP (1u << 18)

__device__ __forceinline__ unsigned xb_ld(unsigned* p)              { return __hip_atomic_load(p, __ATOMIC_RELAXED, __HIP_MEMORY_SCOPE_AGENT); }
__device__ __forceinline__ unsigned xb_add(unsigned* p, unsigned v) { return __hip_atomic_fetch_add(p, v, __ATOMIC_RELAXED, __HIP_MEMORY_SCOPE_AGENT); }
__device__ __forceinline__ unsigned xb_xcc_id() { return (unsigned)__builtin_amdgcn_s_getreg((3 << 11) | 20) & 0xFu; }
#define XB_SPIN(cond, bar) do { unsigned _sp = 0; while (cond) { __builtin_amdgcn_s_sleep(1); \
    if ((++_sp & 255u) == 0u) { if (xb_ld(&(bar)[XB_TMO])) break; if (_sp > XB_SPIN_CAP) { atomicAdd(&(bar)[XB_TMO], 1u); break; } } } } while (0)

struct XcdBarrier {
    unsigned* bar; unsigned x;
    volatile LAS unsigned* st;
};

__device__ __forceinline__ XcdBarrier xcd_barrier_post(unsigned* bar, volatile LAS unsigned* st) {
    XcdBarrier b; b.bar = bar; b.x = xb_xcc_id(); b.st = st;
    if (threadIdx.x == 0) (void)xb_add(&bar[XB_XCNT(b.x)], 1u);
    return b;
}
__device__ __forceinline__ void xcd_barrier_complete(unsigned* bar, unsigned x, unsigned& nloc, unsigned& nx) {
    const unsigned G = gridDim.x * gridDim.y * gridDim.z;
    unsigned sum, cnt, mine, sp = 0u;
    for (;;) {
        sum = 0u; cnt = 0u; mine = 0u;
#pragma unroll
        for (unsigned j = 0; j < 16; ++j) { const unsigned c = xb_ld(&bar[XB_XCNT(j)]); sum += c; cnt += (c > 0u) ? 1u : 0u; mine = (j == x) ? c : mine; }
        if (sum == G) break;
        __builtin_amdgcn_s_sleep(1);
        if ((++sp & 255u) == 0u) { if (xb_ld(&bar[XB_TMO])) break; if (sp > XB_SPIN_CAP) { atomicAdd(&bar[XB_TMO], 1u); break; } }
    }
    nloc = mine > 0u ? mine : 1u; nx = cnt > 0u ? cnt : 1u;
}

__device__ __forceinline__ void xcd_barrier(const XcdBarrier& b) {
    asm volatile("s_waitcnt vmcnt(0)" ::: "memory");
    __syncthreads();
    if (threadIdx.x == 0) {
        unsigned* bar = b.bar;
        __builtin_amdgcn_s_waitcnt(0);
        unsigned nloc = b.st[0], nx = b.st[1];
        if (nloc == 0u) { xcd_barrier_complete(bar, b.x, nloc, nx); b.st[0] = nloc; b.st[1] = nx; }
        const unsigned old = xb_add(&bar[XB_XSUB(b.x)], 1u);
        const unsigned gen = old / nloc;
        if (old + 1u == (gen + 1u) * nloc) {
            __builtin_amdgcn_fence(__ATOMIC_RELEASE, "agent");
            asm volatile("s_waitcnt vmcnt(0)" ::: "memory");
            (void)xb_add(&bar[XB_TOP], 1u);
        }
        const unsigned target = (gen + 1u) * nx;
        asm volatile("buffer_inv sc1" ::: "memory");
        XB_SPIN((int)(xb_ld(&bar[XB_TOP]) - target) < 0, bar);
        asm volatile("s_waitcnt vmcnt(0)" ::: "memory");
    }
    __syncthreads();
}
constexpr int NWAVES = 8;
#ifndef MK_PER_PHASE
#define MK_PER_PHASE 0
#endif
constexpr int D = 1024, MP = 16384, MS = 1024, M = MP + MS, NPROJ = 2816, FF = 4096, NIN = 2820;
constexpr int SEQ = 2048, NB = 8, SB = 128, SL = 8, NCH = 32  ;
constexpr float EPS = 1e-6f;
constexpr size_t MiB = 1u << 20;
constexpr size_t WS_CTL = 0, CTL_ZERO_BYTES = 256 * 1024;
constexpr size_t WS_WDT = 512 * 1024;
constexpr size_t WS_LWT = 640 * 1024;
constexpr size_t WS_WIN = 1 * MiB;
constexpr size_t WS_WOUT = 12 * MiB;
constexpr size_t WS_WUP = 16 * MiB;
constexpr size_t WS_WDN = 32 * MiB;
constexpr size_t WS_XB = 48 * MiB;
constexpr size_t WS_UP = 82 * MiB;
constexpr size_t WS_PROJ = 82 * MiB;
constexpr size_t WS_SSDLOC = 176 * MiB;
constexpr size_t WS_HGLOC = 192 * MiB;
constexpr size_t WS_MIX = 218 * MiB;
constexpr size_t WS_SSQA = 252 * MiB;
constexpr size_t WS_SSQB = 253 * MiB + 512 * 1024;
constexpr size_t WS_SMALL = 255 * MiB;
constexpr size_t WS_DT = 254 * MiB + 640 * 1024;
constexpr size_t WS_END = 256 * MiB;
static_assert(WS_UP + (size_t)M * FF * 2 <= WS_MIX && WS_PROJ + (size_t)M * NPROJ * 2 <= WS_SSDLOC && WS_MIX + (size_t)M * D * 2 <= WS_SSQA && WS_SSQA + (size_t)M * 64 <= WS_SSQB && WS_SSQB + (size_t)M * 64 <= WS_DT && WS_DT + (size_t)M * 16 <= WS_SMALL, "ws map");
constexpr int CW_BAR = 4096;
constexpr int CW_QUEUE = 16384;
constexpr size_t O_Y = 0, O_PK = 17825792, O_PV = O_PK + 262144, O_PSSM = O_PV + 262144, O_PSSMC = O_PSSM + 262144, O_PHG = O_PSSMC + 24576,
                 O_PLRU = O_PHG + 262144, O_PLRUC = O_PLRU + 4096, O_SK = O_PLRUC + 12288, O_SV = O_SK + 4194304, O_SSSM = O_SV + 4194304,
                 O_SSSMC = O_SSSM + 4194304, O_SHG = O_SSSMC + 393216, O_SLRU = O_SHG + 4194304, O_SLRUC = O_SLRU + 65536, O_END = O_SLRUC + 196608;
constexpr int RING_BYTES = 131072, LDSCTL_OFF = RING_BYTES, MISC_OFF = LDSCTL_OFF + 320, SSQ_LDS_OFF = LDSCTL_OFF + 1024, WSCR_OFF = LDSCTL_OFF + 4096, PTAB_OFF = LDSCTL_OFF + 12288, LDS_BYTES = 147456;

typedef unsigned v2u __attribute__((ext_vector_type(2)));

__device__ __forceinline__ float bf2f(unsigned short u) { return __builtin_bit_cast(float, (unsigned)u << 16); }
__device__ __forceinline__ float bflo(unsigned u) { return __builtin_bit_cast(float, u << 16); }
__device__ __forceinline__ float bfhi(unsigned u) { return __builtin_bit_cast(float, u & 0xffff0000u); }
typedef float f32x2_t __attribute__((ext_vector_type(2))); typedef __bf16 bf16x2_t __attribute__((ext_vector_type(2)));
__device__ __forceinline__ unsigned cvtpk_(float lo, float hi) { f32x2_t v = {lo, hi}; bf16x2_t b = __builtin_convertvector(v, bf16x2_t); return __builtin_bit_cast(unsigned, b); }
__device__ __forceinline__ unsigned short f2bf_s(float f) { return (unsigned short)cvtpk_(f, 0.f); }
#define pk2(lo, hi) cvtpk_((lo), (hi))
template <int CTRL, int ROWMASK> __device__ __forceinline__ float dpp_add_(float v) {
    return v + __builtin_bit_cast(float, __builtin_amdgcn_update_dpp(0, __builtin_bit_cast(int, v), CTRL, ROWMASK, 0xF, true));
}
__device__ __forceinline__ float row16_sum(float v) {
    v = dpp_add_<0xB1, 0xF>(v); v = dpp_add_<0x4E, 0xF>(v); v = dpp_add_<0x141, 0xF>(v); v = dpp_add_<0x140, 0xF>(v); return v;
}
__device__ __forceinline__ float half32_sum_hi(float v) {
    return dpp_add_<0x142, 0xA>(row16_sum(v));
}
__device__ __forceinline__ float wave_sum(float v) {
    v = dpp_add_<0x143, 0xC>(half32_sum_hi(v));
    return __builtin_bit_cast(float, __builtin_amdgcn_readlane(__builtin_bit_cast(int, v), 63));
}
__device__ __forceinline__ float rdlane(float v, int l) { return __builtin_bit_cast(float, __builtin_amdgcn_readlane(__builtin_bit_cast(int, v), l)); }
__device__ __forceinline__ float rcpf_(float x) { return __builtin_amdgcn_rcpf(x); }
__device__ __forceinline__ float rsqf_(float x) { return __builtin_amdgcn_rsqf(x); }
__device__ __forceinline__ float sigmoidf_(float x) { return rcpf_(1.0f + __expf(-x)); }
__device__ __forceinline__ float siluf_(float x) { return x * rcpf_(1.0f + __expf(-x)); }
__device__ __forceinline__ float softplusf_(float x) { return x > 20.f ? x : log1pf(__expf(x)); }
__device__ __forceinline__ float geluf_(float x) { const float u = 0.7978845608028654f * (x + 0.044715f * x * x * x); return x * rcpf_(1.0f + __expf(-2.0f * u)); }
__device__ __forceinline__ float one_minus_exp_(float z) {
    const float ser = -z * (1.0f + z * (0.5f + z * (0.16666667f + z * (0.041666668f + z * 0.008333334f))));
    return z > -0.25f ? ser : 1.0f - __expf(z);
}
#define OPQ(p) asm volatile("" : "+v"(p))
__device__ __forceinline__ void ld64s_nt(float (&v)[64], const float* p) {
#pragma unroll
    for (int i0 = 0; i0 < 64; i0 += 8) {
#pragma unroll
        for (int i = 0; i < 8; ++i) v[i0 + i] = __builtin_nontemporal_load(p + i * 64);
        p += 512; OPQ(p); }
}
__device__ __forceinline__ void st64s_nt(const float (&v)[64], float* p) {
#pragma unroll
    for (int i0 = 0; i0 < 64; i0 += 8) {
#pragma unroll
        for (int i = 0; i < 8; ++i) __builtin_nontemporal_store(v[i0 + i], p + i * 64);
        p += 512; OPQ(p); }
}
__device__ __forceinline__ void ld64s(float (&v)[64], const float* p) {
#pragma unroll
    for (int i0 = 0; i0 < 64; i0 += 8) {
#pragma unroll
        for (int i = 0; i < 8; ++i) v[i0 + i] = p[i * 64];
        p += 512; OPQ(p); }
}
__device__ __forceinline__ void st64s(const float (&v)[64], float* p) {
#pragma unroll
    for (int i0 = 0; i0 < 64; i0 += 8) {
#pragma unroll
        for (int i = 0; i < 8; ++i) p[i * 64] = v[i0 + i];
        p += 512; OPQ(p); }
}
struct Frame {
    LAS unsigned char* lds;
    volatile LAS unsigned* MISC;
    gu32* ctl;
    int tid, lane, wave, vcu, G;
    float* out; unsigned char* ws;
};
__device__ __forceinline__ const float* pin_(LAS unsigned char* lds, int i) {
    const unsigned long long v = *(const volatile LAS unsigned long long*)(lds + PTAB_OFF + 8 * i);
    const unsigned lo = (unsigned)__builtin_amdgcn_readfirstlane((int)(unsigned)v), hi = (unsigned)__builtin_amdgcn_readfirstlane((int)(unsigned)(v >> 32));
    return (const float*)(GAS const float*)(((unsigned long long)hi << 32) | lo);
}
#define PIN(i) pin_(F.lds, (i))
enum { I_XP = 0, I_XS, I_CK, I_CV, I_SSSM, I_SSSMC, I_SHG, I_SLRU, I_SLRUC, I_NMIX, I_WIN, I_SCW, I_SCB, I_SDTB, I_SALOG, I_SD, I_SNW, I_SINK, I_RELB, I_HLB, I_HNW,
       I_LCW, I_LCB, I_LWA, I_LBA, I_LWX, I_LBX, I_LLAM, I_WOUT, I_NMLP, I_WUP, I_WDN, I_NF };

__device__ __forceinline__ void p0_transpose_item(const float* W, int K, int Nsrc, bf16* WT, int n_dst0, int n_src0, int k0, const float* scale, LAS float* scr, int lane) {
    float wv[32];
#pragma unroll
    for (int i = 0; i < 32; ++i) wv[i] = __builtin_nontemporal_load(W + (size_t)(k0 + 2 * i + (lane >> 5)) * Nsrc + n_src0 + (lane & 31));
#pragma unroll
    for (int i = 0; i < 32; ++i) { const int kk = 2 * i + (lane >> 5); const float sc = scale ? scale[k0 + kk] : 1.0f; scr[kk * 33 + (lane & 31)] = wv[i] * sc; }
    LDS_WAIT(); asm volatile("" ::: "memory");
    const int c = lane & 7;
    const __amdgpu_buffer_rsrc_t wrsrc = __builtin_amdgcn_make_buffer_rsrc((void*)WT, 0, 16 * 1024 * 1024, 0x00020000);
#pragma unroll
    for (int j = 0; j < 4; ++j) { const int n = (lane >> 3) + 8 * j; const LAS float* s = scr + (8 * c) * 33 + n;
        v4u o; o.x = pk2(s[0 * 33], s[1 * 33]); o.y = pk2(s[2 * 33], s[3 * 33]); o.z = pk2(s[4 * 33], s[5 * 33]); o.w = pk2(s[6 * 33], s[7 * 33]);
        __builtin_amdgcn_raw_buffer_store_b128(o, wrsrc, (unsigned)(((size_t)(n_dst0 + n) * K + k0 + 8 * c) * 2), 0, 16); }
    LDS_WAIT(); asm volatile("" ::: "memory");
}
__device__ __forceinline__ void p0_prologue(Frame& F) {
    LAS float* scr = (LAS float*)(F.lds + F.wave * 16384);
    const int gw = F.vcu * NWAVES + F.wave, NGW = F.G * NWAVES;
    constexpr int I_IN = 16 * 88, I_OUT = 16 * 32, I_UP = 16 * 128, I_DN = 64 * 32, I_L = I_IN + I_OUT + I_UP + I_DN;
    for (int it = gw; it < 2 * I_L; it += NGW) {
        const int l = it / I_L; int r = it % I_L;
        if (r < I_IN) { const int kb = r / 88, nb = r % 88, nd = 32 * nb, ns = nd < 768 ? nd : nd + 4;
            p0_transpose_item(PIN(I_WIN) + (size_t)l * D * NIN, D, NIN, (bf16*)(F.ws + WS_WIN) + (size_t)l * NPROJ * D, nd, ns, 64 * kb, PIN(I_NMIX) + l * D, scr, F.lane); continue; } r -= I_IN;
        if (r < I_OUT) { const int kb = r / 32, nb = r % 32;
            p0_transpose_item(PIN(I_WOUT) + (size_t)l * D * D, D, D, (bf16*)(F.ws + WS_WOUT) + (size_t)l * D * D, 32 * nb, 32 * nb, 64 * kb, nullptr, scr, F.lane); continue; } r -= I_OUT;
        if (r < I_UP) { const int kb = r / 128, nb = r % 128;
            p0_transpose_item(PIN(I_WUP) + (size_t)l * D * FF, D, FF, (bf16*)(F.ws + WS_WUP) + (size_t)l * FF * D, 32 * nb, 32 * nb, 64 * kb, PIN(I_NMLP) + l * D, scr, F.lane); continue; } r -= I_UP;
        { const int kb = r / 32, nb = r % 32;
            p0_transpose_item(PIN(I_WDN) + (size_t)l * FF * D, FF, D, (bf16*)(F.ws + WS_WDN) + (size_t)l * D * FF, 32 * nb, 32 * nb, 64 * kb, nullptr, scr, F.lane); }
    }
    for (int e = gw * 64 + F.lane; e < 2 * 4 * D; e += NGW * 64) { const int l = e / (4 * D), h = (e / D) % 4, k = e % D;
        ((float*)(F.ws + WS_WDT))[e] = PIN(I_NMIX)[l * D + k] * PIN(I_WIN)[(size_t)l * D * NIN + (size_t)k * NIN + 768 + h]; }
    for (int e = gw * 64 + F.lane; e < 2 * 2 * 4 * 4096; e += NGW * 64) { const int l = e >> 15, gate = (e >> 14) & 1, blk = (e >> 12) & 3, j = (e >> 6) & 63, i = e & 63;
        ((bf16*)(F.ws + WS_LWT))[e] = f2bf_s((gate ? PIN(I_LWX) : PIN(I_LWA))[(((size_t)l * 4 + blk) * 64 + i) * 64 + j]); }
    bf16* xb = (bf16*)(F.ws + WS_XB); float* ssq = (float*)(F.ws + WS_SSQA); float* dto = (float*)(F.ws + WS_DT);
    f32x4 wdt[4][4];
#pragma unroll
    for (int j = 0; j < 4; ++j)
#pragma unroll
        for (int e = 0; e < 4; ++e) { const int k = 256 * j + 4 * F.lane + e; wdt[j][e] = *(const f32x4*)(PIN(I_WIN) + (size_t)k * NIN + 768) * PIN(I_NMIX)[k]; }
    const float dtbias = PIN(I_SDTB)[F.lane & 3];
    for (int m0 = gw; m0 < M; m0 += 2 * NGW) {
        f32x4 v[2][4];
#pragma unroll
        for (int rr = 0; rr < 2; ++rr) { const int m = (m0 + rr * NGW < M) ? m0 + rr * NGW : m0;
            const float* xrow = (m < MP) ? PIN(I_XP) + (size_t)m * D : PIN(I_XS) + (size_t)(m - MP) * D;
#pragma unroll
            for (int j = 0; j < 4; ++j) v[rr][j] = __builtin_nontemporal_load((const f32x4*)xrow + F.lane + 64 * j); }
#pragma unroll
        for (int rr = 0; rr < 2; ++rr) { const int m = m0 + rr * NGW; if (m >= M) break;
            float s = 0.f; unsigned long long* o8 = (unsigned long long*)(xb + (size_t)m * D) + F.lane;
#pragma unroll
            for (int j = 0; j < 4; ++j) { const f32x4 q = v[rr][j]; s += (q.x * q.x + q.y * q.y) + (q.z * q.z + q.w * q.w);
                o8[64 * j] = (unsigned long long)pk2(q.x, q.y) | ((unsigned long long)pk2(q.z, q.w) << 32); }
            s = wave_sum(s);
            if (F.lane < 16) ssq[(size_t)m * 16 + F.lane] = (F.lane == 0) ? s : 0.f;
            f32x4 dd = {0.f, 0.f, 0.f, 0.f};
#pragma unroll
            for (int j = 0; j < 4; ++j) { const f32x4 q = v[rr][j]; dd += wdt[j][0] * q.x + wdt[j][1] * q.y + wdt[j][2] * q.z + wdt[j][3] * q.w; }
            const float d0 = wave_sum(dd.x), d1 = wave_sum(dd.y), d2 = wave_sum(dd.z), d3 = wave_sum(dd.w);
            const float rs = rsqf_(s * (1.0f / D) + EPS);
            const float dsel = (F.lane & 3) == 0 ? d0 : (F.lane & 3) == 1 ? d1 : (F.lane & 3) == 2 ? d2 : d3;
            if (F.lane < 4) dto[(size_t)m * 4 + F.lane] = softplusf_(dsel * rs + dtbias); }
    }
}
__device__ __forceinline__ void final_norm(Frame& F) {
    const int gw = F.vcu * NWAVES + F.wave, NGW = F.G * NWAVES;
    const float* ssq = (const float*)(F.ws + WS_SSQA);
    f32x4 wv[4];
#pragma unroll
    for (int j = 0; j < 4; ++j) wv[j] = ((const f32x4*)PIN(I_NF) + F.lane)[64 * j];
#pragma unroll 1
    for (int m0 = (NGW - 1 - gw); m0 < MP; m0 += 4 * NGW) {
        f32x4 v[4][4]; float sq[4];
#pragma unroll
        for (int rr = 0; rr < 4; ++rr) { const int m = (m0 + rr * NGW < MP) ? m0 + rr * NGW : m0; sq[rr] = ssq[(size_t)m * 16 + (F.lane & 15)];
#pragma unroll
            for (int j = 0; j < 4; ++j) { const v2u u = __builtin_nontemporal_load((const v2u*)((const bf16*)(F.ws + WS_XB) + (size_t)m * D) + F.lane + 64 * j); v[rr][j] = (f32x4){bflo(u.x), bfhi(u.x), bflo(u.y), bfhi(u.y)}; } }
#pragma unroll
        for (int rr = 0; rr < 4; ++rr) { const int m = m0 + rr * NGW; if (m >= MP) break;
            float s = sq[rr]; s = row16_sum(s);
            const float rs = rsqf_(s * (1.0f / D) + EPS);
#pragma unroll
            for (int j = 0; j < 4; ++j) __builtin_nontemporal_store(v[rr][j] * rs * wv[j], (f32x4*)(F.out + (size_t)m * D) + F.lane + 64 * j); }
    }
}

constexpr int G4_KP = 8;
template <bool FINAL> __device__ __forceinline__ void sample_reduce(Frame& F) {
    const int gw = F.vcu * NWAVES + F.wave, NGW = F.G * NWAVES, lane = F.lane;
    const bf16* slab = (const bf16*)(F.ws + WS_MIX); bf16* xb = (bf16*)(F.ws + WS_XB); float* ssq = (float*)(F.ws + WS_SSQA);
    f32x4 wdt[4][4];
    float dtbias = 0.f;
    if (!FINAL) {
#pragma unroll
        for (int j = 0; j < 4; ++j)
#pragma unroll
            for (int h = 0; h < 4; ++h) wdt[j][h] = *(const f32x4*)((const float*)(F.ws + WS_WDT) + (size_t)(4 + h) * D + 256 * j + 4 * lane);
        dtbias = PIN(I_SDTB)[4 + (lane & 3)];
    }
    for (int rs = gw; rs < MS; rs += NGW) {
        const int pmr = rs >> 8, rr = rs & 255, row = MP + rs;
        f32x4 acc[4]; float* xrow = F.out + (size_t)row * D;
#pragma unroll
        for (int j = 0; j < 4; ++j) { const v2u u = *(const v2u*)(xb + (size_t)row * D + j * 256 + lane * 4); acc[j] = (f32x4){bflo(u.x), bfhi(u.x), bflo(u.y), bfhi(u.y)}; }
#pragma unroll
        for (int j = 0; j < 4; ++j)
#pragma unroll
            for (int kp = 0; kp < G4_KP; ++kp) { const v2u u = __builtin_nontemporal_load((const v2u*)(slab + (size_t)((pmr * 4 + j) * G4_KP + kp) * 65536 + rr * 256 + lane * 4)); acc[j] += (f32x4){bflo(u.x), bfhi(u.x), bflo(u.y), bfhi(u.y)}; }
        float s = 0.f;
#pragma unroll
        for (int j = 0; j < 4; ++j) { const f32x4 v = acc[j]; s += (v.x * v.x + v.y * v.y) + (v.z * v.z + v.w * v.w); }
        s = wave_sum(s);
        if (FINAL) {
            const float rsn = rsqf_(s * (1.0f / D) + EPS);
#pragma unroll
            for (int j = 0; j < 4; ++j) __builtin_nontemporal_store(acc[j] * rsn * *(const f32x4*)(PIN(I_NF) + j * 256 + lane * 4), (f32x4*)(xrow + j * 256 + lane * 4));
        } else {
#pragma unroll
            for (int j = 0; j < 4; ++j) { const f32x4 v = acc[j];
                v2u o; o.x = pk2(v.x, v.y); o.y = pk2(v.z, v.w); *(v2u*)(xb + (size_t)row * D + j * 256 + lane * 4) = o; }
            if (lane < 16) ssq[(size_t)row * 16 + lane] = (lane == 0) ? s : 0.f;
            float d[4];
#pragma unroll
            for (int h = 0; h < 4; ++h) { float t = 0.f;
#pragma unroll
                for (int j = 0; j < 4; ++j) { const f32x4 p = acc[j] * wdt[j][h]; t += (p.x + p.y) + (p.z + p.w); }
                d[h] = wave_sum(t); }
            const float dsel = (lane & 3) == 0 ? d[0] : (lane & 3) == 1 ? d[1] : (lane & 3) == 2 ? d[2] : d[3];
            if (lane < 4) ((float*)(F.ws + WS_DT))[(size_t)row * 4 + lane] = softplusf_(dsel * rsqf_(s * (1.0f / D) + EPS) + dtbias);
        }
    }
}
__device__ __forceinline__ void dt_pass(Frame& F, int l, int MR) {
    const int gw = F.vcu * NWAVES + F.wave, NGW = F.G * NWAVES, lane = F.lane;
    const bf16* xb = (const bf16*)(F.ws + WS_XB); const float* ssq = (const float*)(F.ws + WS_SSQA); float* dto = (float*)(F.ws + WS_DT);
    const float* wd = (const float*)(F.ws + WS_WDT) + (size_t)l * 4 * D + lane * 16;
    float w[4][16];
#pragma unroll
    for (int h = 0; h < 4; ++h)
#pragma unroll
        for (int i = 0; i < 16; i += 4) { const f32x4 v = *(const f32x4*)(wd + h * D + i); w[h][i] = v.x; w[h][i + 1] = v.y; w[h][i + 2] = v.z; w[h][i + 3] = v.w; }
    const float bias = PIN(I_SDTB)[l * 4 + (lane & 3)];
#pragma unroll 1
    for (int m0 = gw; m0 < MR; m0 += 4 * NGW) {
        v4u a[4], b[4]; float sq[4];
#pragma unroll
        for (int r = 0; r < 4; ++r) { const int m = m0 + r * NGW < MR ? m0 + r * NGW : m0;
            a[r] = *(const v4u*)(xb + (size_t)m * D + lane * 16); b[r] = *(const v4u*)(xb + (size_t)m * D + lane * 16 + 8); sq[r] = ssq[(size_t)m * 16 + (lane & 15)]; }
#pragma unroll
        for (int r = 0; r < 4; ++r) {
            const int m = m0 + r * NGW;
            float x[16] = {bflo(a[r].x), bfhi(a[r].x), bflo(a[r].y), bfhi(a[r].y), bflo(a[r].z), bfhi(a[r].z), bflo(a[r].w), bfhi(a[r].w),
                           bflo(b[r].x), bfhi(b[r].x), bflo(b[r].y), bfhi(b[r].y), bflo(b[r].z), bfhi(b[r].z), bflo(b[r].w), bfhi(b[r].w)};
            float d[4];
#pragma unroll
            for (int h = 0; h < 4; ++h) { float s = 0.f;
#pragma unroll
                for (int i = 0; i < 16; ++i) s += x[i] * w[h][i];
                d[h] = wave_sum(s); }
            float q = sq[r]; q = row16_sum(q);
            const float rs = rsqf_(q * (1.0f / D) + EPS);
            const float dsel = (lane & 3) == 0 ? d[0] : (lane & 3) == 1 ? d[1] : (lane & 3) == 2 ? d[2] : d[3];
            if (lane < 4 && m < MR) dto[(size_t)m * 4 + lane] = softplusf_(dsel * rs + bias);
        }
    }
}

__device__ __forceinline__ float row_rstd(const float* ssq, int row, int lane) {
    float s = ssq[(size_t)row * 16 + (lane & 15)]; s = row16_sum(s);
    return rsqf_(s * (1.0f / D) + EPS);
}
#define PROJ(F) ((const bf16*)((F).ws + WS_PROJ))
template <bool WRITE_Y>
__device__ __forceinline__ void ssd_wave(Frame& F, int l, int h, int row0, int nsteps, int hist, const float* cs, float (&S)[64], float& logdec,
                                         LAS float* ylds  , LAS float* ssql  ) {
    const int lane = F.lane, g = h >> 1;
    const int cx = h * 64 + lane, cB = 256 + g * 64 + lane, cC = 384 + g * 64 + lane;
    const float* cw = PIN(I_SCW) + (size_t)l * 4 * 512; const float* cb = PIN(I_SCB) + (size_t)l * 512;
    float wx[4], wB[4], wC[4];
#pragma unroll
    for (int k = 0; k < 4; ++k) { wx[k] = cw[k * 512 + cx]; wB[k] = cw[k * 512 + cB]; wC[k] = cw[k * 512 + cC]; }
    const float bx = cb[cx], bB = cb[cB], bC = cb[cC];
    const float A = -__expf(PIN(I_SALOG)[l * 4 + h]), Dh = PIN(I_SD)[l * 4 + h];
    const bf16* proj = PROJ(F);
    const float dtv = (lane < nsteps) ? ((const float*)(F.ws + WS_DT))[(size_t)(row0 + lane) * 4 + h] : 0.f;
    float x1 = 0.f, x2 = 0.f, x3 = 0.f, B1 = 0.f, B2 = 0.f, B3 = 0.f, C1 = 0.f, C2 = 0.f, C3 = 0.f;
    if (hist == 1) {
        const bf16* p = proj + (size_t)(row0 - 1) * NPROJ + 256;
        x1 = bf2f(p[cx]); B1 = bf2f(p[cB]); C1 = bf2f(p[cC]); p -= NPROJ; x2 = bf2f(p[cx]); B2 = bf2f(p[cB]); C2 = bf2f(p[cC]); p -= NPROJ; x3 = bf2f(p[cx]); B3 = bf2f(p[cB]); C3 = bf2f(p[cC]);
    } else if (hist == 2) {
        x3 = cs[cx]; B3 = cs[cB]; C3 = cs[cC]; x2 = cs[512 + cx]; B2 = cs[512 + cB]; C2 = cs[512 + cC]; x1 = cs[1024 + cx]; B1 = cs[1024 + cB]; C1 = cs[1024 + cC];
    }
    LAS float* bc = (LAS float*)(F.lds + WSCR_OFF) + F.wave * 256;
    const int last = nsteps - 1;
#define SSD_LOAD(xv, Bv, Cv, zv, tt) do { const bf16* p_ = proj + (size_t)(row0 + ((tt) < last ? (tt) : last)) * NPROJ; xv = bf2f(p_[256 + cx]); Bv = bf2f(p_[256 + cB]); Cv = bf2f(p_[256 + cC]); zv = WRITE_Y ? bf2f(p_[cx]) : 0.f; } while (0)
    float xa, Ba, Ca, za, xn, Bn, Cn, zn, xm, Bm, Cm, zm;
    SSD_LOAD(xa, Ba, Ca, za, 0); SSD_LOAD(xn, Bn, Cn, zn, 1);
#pragma unroll 4
    for (int t = 0; t < nsteps; ++t) {
        SSD_LOAD(xm, Bm, Cm, zm, t + 2);
        const float xc = bx + wx[0] * x3 + wx[1] * x2 + wx[2] * x1 + wx[3] * xa; x3 = x2; x2 = x1; x1 = xa;
        const float Bc = bB + wB[0] * B3 + wB[1] * B2 + wB[2] * B1 + wB[3] * Ba; B3 = B2; B2 = B1; B1 = Ba;
        const float Cc = bC + wC[0] * C3 + wC[1] * C2 + wC[2] * C1 + wC[3] * Ca; C3 = C2; C2 = C1; C1 = Ca;
        const float xs = siluf_(xc);
        bc[lane] = siluf_(Bc); if (WRITE_Y) bc[64 + lane] = siluf_(Cc);
        const float dt = rdlane(dtv, t), dA = __expf(dt * A), xdt = xs * dt;
        logdec += dt * A;
        float y0 = 0.f, y1 = 0.f;
#pragma unroll
        for (int n = 0; n < 64; n += 4) {
            const f32x4 bv = *(const LAS f32x4*)(bc + n);
            S[n] = dA * S[n] + xdt * bv.x; S[n + 1] = dA * S[n + 1] + xdt * bv.y; S[n + 2] = dA * S[n + 2] + xdt * bv.z; S[n + 3] = dA * S[n + 3] + xdt * bv.w;
            if (WRITE_Y) { const f32x4 cv = *(const LAS f32x4*)(bc + 64 + n); y0 += S[n] * cv.x + S[n + 2] * cv.z; y1 += S[n + 1] * cv.y + S[n + 3] * cv.w; }
        }
        if (WRITE_Y) {
            const float yg = ((y0 + y1) + Dh * xs) * siluf_(za);
            ylds[t * 256 + cx] = yg;
            const float q = wave_sum(yg * yg);
            if (lane == 0) ssql[t * 4 + h] = q;
        }
        xa = xn; Ba = Bn; Ca = Cn; za = zn; xn = xm; Bn = Bm; Cn = Cm; zn = zm;
    }
#undef SSD_LOAD
}
__device__ __forceinline__ void ssd_norm_store(Frame& F, int l, int h, int row0, int nsteps, const LAS float* ylds, const LAS float* ssql) {
    const int cx = h * 64 + F.lane; const float nw = PIN(I_SNW)[l * 256 + cx];
    bf16* mix = (bf16*)(F.ws + WS_MIX);
#pragma unroll 8
    for (int t = 0; t < nsteps; ++t) {
        const float q = (ssql[t * 4] + ssql[t * 4 + 1]) + (ssql[t * 4 + 2] + ssql[t * 4 + 3]);
        const float rs = rsqf_(q * (1.0f / 256.0f) + EPS);
        mix[(size_t)(row0 + t) * D + cx] = f2bf_s(ylds[t * 256 + cx] * rs * nw);
    }
}
__device__ __forceinline__ void ssd_conv_out(Frame& F, int h, int r0, float* dst) {
    const bf16* proj = PROJ(F); const int lane = F.lane, g = h >> 1;
#pragma unroll
    for (int j = 0; j < 3; ++j) { const bf16* p = proj + (size_t)(r0 + j) * NPROJ + 256; dst[j * 512 + h * 64 + lane] = bf2f(p[h * 64 + lane]);
        if ((h & 1) == 0) { dst[j * 512 + 256 + g * 64 + lane] = bf2f(p[256 + g * 64 + lane]); dst[j * 512 + 384 + g * 64 + lane] = bf2f(p[384 + g * 64 + lane]); } }
}
__device__ __forceinline__ void ssd_item(Frame& F, int l, int kind, int it) {
#ifdef SKIP_SSD
    return;
#endif
    const int w = F.wave, h = w & 3, half = w >> 2, lane = F.lane;
    LAS float* ylds = (LAS float*)F.lds + half * (64 * 256); LAS float* ssql = (LAS float*)(F.lds + SSQ_LDS_OFF) + half * 256;
    float* sloc = (float*)(F.ws + WS_SSDLOC); float* decS = (float*)(F.ws + WS_SMALL);
    float S[64]; float logdec = 0.f;
#pragma unroll
    for (int n = 0; n < 64; ++n) S[n] = 0.f;
    if (kind == 2) {
        const int b = it * 2 + half, row0 = MP + b * SL;
        const float* st = PIN(I_SSSM) + (((size_t)l * SB + b) * 4 + h) * 4096 + lane * 64;
#pragma unroll
        for (int n = 0; n < 64; n += 4) { const f32x4 v = *(const f32x4*)(st + n); S[n] = v.x; S[n + 1] = v.y; S[n + 2] = v.z; S[n + 3] = v.w; }
        ssd_wave<true>(F, l, h, row0, SL, 2, PIN(I_SSSMC) + ((size_t)l * SB + b) * 1536, S, logdec, ylds, ssql);
        float* so = F.out + O_SSSM + (((size_t)l * SB + b) * 4 + h) * 4096 + lane * 64;
#pragma unroll
        for (int n = 0; n < 64; n += 4) *(f32x4*)(so + n) = (f32x4){S[n], S[n + 1], S[n + 2], S[n + 3]};
        ssd_conv_out(F, h, row0 + SL - 3, F.out + O_SSSMC + ((size_t)l * SB + b) * 1536);
        __syncthreads();
        ssd_norm_store(F, l, h, row0, SL, ylds, ssql);
        __syncthreads();
        return;
    }
    const int b = it / 16, c = (it % 16) * 2 + half, row0 = b * SEQ + c * 64, sidx = (b * 4 + h) * NCH + c;
    if (kind == 0) {
        ssd_wave<false>(F, l, h, row0, 64, c == 0 ? 0 : 1, nullptr, S, logdec, ylds, ssql);
        st64s(S, sloc + (size_t)sidx * 4096 + lane);
        if (lane == 0) decS[sidx] = __expf(logdec);
        return;
    }
    ld64s(S, sloc + (size_t)sidx * 4096 + lane);
    ssd_wave<true>(F, l, h, row0, 64, c == 0 ? 0 : 1, nullptr, S, logdec, ylds, ssql);
    if (c == NCH - 1) {
        float* so = F.out + O_PSSM + (((size_t)l * NB + b) * 4 + h) * 4096 + lane * 64;
#pragma unroll
        for (int n = 0; n < 64; n += 4) *(f32x4*)(so + n) = (f32x4){S[n], S[n + 1], S[n + 2], S[n + 3]};
        ssd_conv_out(F, h, row0 + 61, F.out + O_PSSMC + ((size_t)l * NB + b) * 1536);
    }
    __syncthreads();
    ssd_norm_store(F, l, h, row0, 64, ylds, ssql);
    __syncthreads();
}

template <bool WRITE_Y>
__device__ __forceinline__ void hgrn_wave(Frame& F, int l, int h, int row0, int nsteps, float (&S)[64], float& decv) {
    const int lane = F.lane, ch = h * 64 + lane;
    const float lbk = (l == 0) ? 0.f : sigmoidf_(PIN(I_HLB)[256 + ch] - PIN(I_HLB)[ch]);
    const float nw = PIN(I_HNW)[l * 256 + ch];
    const bf16* proj = PROJ(F); bf16* mix = (bf16*)(F.ws + WS_MIX);
    LAS float* bc = (LAS float*)(F.lds + WSCR_OFF) + F.wave * 256;
    const int last = nsteps - 1;
#define HG_LOAD(qv_, fv_, iv_, gv_, tt) do { const bf16* p_ = proj + (size_t)(row0 + ((tt) < last ? (tt) : last)) * NPROJ + ch; qv_ = bf2f(p_[1280]); fv_ = bf2f(p_[1536]); iv_ = bf2f(p_[1792]); gv_ = WRITE_Y ? bf2f(p_[2048]) : 0.f; } while (0)
    float qa, fa, ia, ga, qn, fn, in_, gn, qm, fm, im, gm;
    HG_LOAD(qa, fa, ia, ga, 0); HG_LOAD(qn, fn, in_, gn, 1);
#pragma unroll 4
    for (int t = 0; t < nsteps; ++t) {
        HG_LOAD(qm, fm, im, gm, t + 2);
        const float sg = sigmoidf_(fa), f = lbk + (1.0f - lbk) * sg, kk = (1.0f - lbk) * (1.0f - sg), iv = ia;
        decv *= f;
        bc[lane] = f; bc[64 + lane] = kk; if (WRITE_Y) bc[128 + lane] = qa;
        float o0 = 0.f, o1 = 0.f;
#pragma unroll
        for (int k = 0; k < 64; k += 4) {
            const f32x4 fv = *(const LAS f32x4*)(bc + k), kv = *(const LAS f32x4*)(bc + 64 + k);
            S[k] = fv.x * S[k] + kv.x * iv; S[k + 1] = fv.y * S[k + 1] + kv.y * iv; S[k + 2] = fv.z * S[k + 2] + kv.z * iv; S[k + 3] = fv.w * S[k + 3] + kv.w * iv;
            if (WRITE_Y) { const f32x4 qv = *(const LAS f32x4*)(bc + 128 + k); o0 += qv.x * S[k] + qv.z * S[k + 2]; o1 += qv.y * S[k + 1] + qv.w * S[k + 3]; }
        }
        if (WRITE_Y) {
            const float o = o0 + o1; const float ms = wave_sum(o * o) * (1.0f / 64.0f);
            mix[(size_t)(row0 + t) * D + 512 + ch] = f2bf_s(o * (rsqf_(ms + EPS)) * nw * sigmoidf_(ga));
        }
        qa = qn; fa = fn; ia = in_; ga = gn; qn = qm; fn = fm; in_ = im; gn = gm;
    }
#undef HG_LOAD
}
__device__ __forceinline__ void hgrn_item(Frame& F, int l, int kind, int wi) {
#ifdef SKIP_HG
    return;
#endif
    const int lane = F.lane;
    float* sloc = (float*)(F.ws + WS_HGLOC); float* decH = (float*)(F.ws + WS_SMALL) + 1024;
    float S[64]; float decv = 1.0f;
#pragma unroll
    for (int k = 0; k < 64; ++k) S[k] = 0.f;
    if (kind == 2) {
        const int b = wi >> 2, h = wi & 3, row0 = MP + b * SL;
        ld64s_nt(S, PIN(I_SHG) + (((size_t)l * SB + b) * 4 + h) * 4096 + lane);
        hgrn_wave<true>(F, l, h, row0, SL, S, decv);
        st64s_nt(S, F.out + O_SHG + (((size_t)l * SB + b) * 4 + h) * 4096 + lane);
        return;
    }
    const int b = wi / 128, h = (wi / 32) % 4, c = wi % 32, row0 = b * SEQ + c * 64, sidx = (b * 4 + h) * NCH + c;
    if (kind == 0) {
        hgrn_wave<false>(F, l, h, row0, 64, S, decv);
        st64s(S, sloc + (size_t)sidx * 4096 + lane);
        decH[(size_t)sidx * 64 + lane] = decv;
        return;
    }
    ld64s(S, sloc + (size_t)sidx * 4096 + lane);
    hgrn_wave<true>(F, l, h, row0, 64, S, decv);
    if (c == NCH - 1) {
        st64s(S, F.out + O_PHG + (((size_t)l * NB + b) * 4 + h) * 4096 + lane);
    }
}

template <bool WRITE_Y>
__device__ __forceinline__ void lru_wave(Frame& F, int l, int blk, int row0, int nsteps, int hist, const float* cs  , float& hst, float& aprod) {
    const int lane = F.lane, ch = blk * 64 + lane;
    const float* cw = PIN(I_LCW) + (size_t)l * 4 * 256; const float cb = PIN(I_LCB)[l * 256 + ch];
    const float w0 = cw[ch], w1 = cw[256 + ch], w2 = cw[512 + ch], w3 = cw[768 + ch];
    const float sp = softplusf_(-PIN(I_LLAM)[l * 256 + ch]);
    const bf16* proj = PROJ(F); bf16* mix = (bf16*)(F.ws + WS_MIX);
    LAS float* bc = (LAS float*)(F.lds + WSCR_OFF) + F.wave * 256;
    LAS float* la = (LAS float*)F.lds + F.wave * 4096;
    const int last = nsteps - 1;
    float h1 = 0.f, h2 = 0.f, h3 = 0.f;
    if (hist == 1) { const bf16* p = proj + (size_t)(row0 - 1) * NPROJ + 2304 + ch; h1 = bf2f(p[0]); h2 = bf2f(p[-NPROJ]); h3 = bf2f(p[-2 * NPROJ]); }
    else if (hist == 2) { h3 = cs[ch]; h2 = cs[256 + ch]; h1 = cs[512 + ch]; }
    float wg[64];
#define LRU_LOAD(xv_, gv_, tt, GATE) do { const bf16* p_ = proj + (size_t)(row0 + ((tt) < last ? (tt) : last)) * NPROJ + ch; xv_ = bf2f(p_[2304]); gv_ = (GATE) ? bf2f(p_[2560]) : 0.f; } while (0)
    ld64s(wg, PIN(I_LWA) + ((size_t)(l * 4 + blk) * 64) * 64 + lane);
    {
        const float ba = PIN(I_LBA)[l * 256 + ch];
        float x1 = h1, x2 = h2, x3 = h3, xa, ga, xn, gn, xm, gm;
        LRU_LOAD(xa, ga, 0, false); LRU_LOAD(xn, gn, 1, false);
#pragma unroll 4
        for (int t = 0; t < nsteps; ++t) {
            LRU_LOAD(xm, gm, t + 2, false);
            const float xc = cb + w0 * x3 + w1 * x2 + w2 * x1 + w3 * xa; x3 = x2; x2 = x1; x1 = xa;
            bc[lane] = xc;
            float r0 = ba, r1 = 0.f;
#pragma unroll
            for (int k = 0; k < 64; k += 4) { const f32x4 xv = *(const LAS f32x4*)(bc + k); r0 += xv.x * wg[k] + xv.z * wg[k + 2]; r1 += xv.y * wg[k + 1] + xv.w * wg[k + 3]; }
            la[t * 64 + lane] = -8.0f * sigmoidf_(r0 + r1) * sp;
            xa = xn; xn = xm; (void)ga; (void)gn; (void)gm;
        }
    }
    ld64s(wg, PIN(I_LWX) + ((size_t)(l * 4 + blk) * 64) * 64 + lane);
    {
        const float bxx = PIN(I_LBX)[l * 256 + ch];
        float x1 = h1, x2 = h2, x3 = h3, xa, ga, xn, gn, xm, gm;
        LRU_LOAD(xa, ga, 0, WRITE_Y); LRU_LOAD(xn, gn, 1, WRITE_Y);
#pragma unroll 4
        for (int t = 0; t < nsteps; ++t) {
            LRU_LOAD(xm, gm, t + 2, WRITE_Y);
            const float xc = cb + w0 * x3 + w1 * x2 + w2 * x1 + w3 * xa; x3 = x2; x2 = x1; x1 = xa;
            bc[lane] = xc;
            float r0 = bxx, r1 = 0.f;
#pragma unroll
            for (int k = 0; k < 64; k += 4) { const f32x4 xv = *(const LAS f32x4*)(bc + k); r0 += xv.x * wg[k] + xv.z * wg[k + 2]; r1 += xv.y * wg[k + 1] + xv.w * wg[k + 3]; }
            const float ig = sigmoidf_(r0 + r1), log_a = la[t * 64 + lane];
            const float a = __expf(log_a), u = __builtin_amdgcn_sqrtf(one_minus_exp_(2.0f * log_a)) * (ig * xc);
            hst = a * hst + u; aprod *= a;
            if (WRITE_Y) mix[(size_t)(row0 + t) * D + 768 + ch] = f2bf_s(hst * geluf_(ga));
            xa = xn; ga = gn; xn = xm; gn = gm;
        }
    }
#undef LRU_LOAD
}
__device__ __forceinline__ void lru_item(Frame& F, int l, int kind, int wi) {
#ifdef SKIP_LRU
    return;
#endif
    const int lane = F.lane; const bf16* proj = PROJ(F);
    float* lruH = (float*)(F.ws + WS_SMALL) + 1024 + 65536; float* lruA = lruH + 65536;
    float hst = 0.f, aprod = 1.0f;
    if (kind == 2) {
        const int b = wi >> 2, blk = wi & 3, ch = blk * 64 + lane, row0 = MP + b * SL;
        hst = PIN(I_SLRU)[((size_t)l * SB + b) * 256 + ch];
        lru_wave<true>(F, l, blk, row0, SL, 2, PIN(I_SLRUC) + ((size_t)l * SB + b) * 768, hst, aprod);
        F.out[O_SLRU + ((size_t)l * SB + b) * 256 + ch] = hst;
#pragma unroll
        for (int j = 0; j < 3; ++j) F.out[O_SLRUC + ((size_t)l * SB + b) * 768 + j * 256 + ch] = bf2f(proj[(size_t)(row0 + SL - 3 + j) * NPROJ + 2304 + ch]);
        return;
    }
    const int b = wi / 128, c = (wi / 4) % 32, blk = wi % 4, ch = blk * 64 + lane, row0 = b * SEQ + c * 64;
    if (kind == 0) {
        lru_wave<false>(F, l, blk, row0, 64, c == 0 ? 0 : 1, nullptr, hst, aprod);
        lruH[(size_t)(b * NCH + c) * 256 + ch] = hst; lruA[(size_t)(b * NCH + c) * 256 + ch] = aprod;
        return;
    }
    hst = lruH[(size_t)(b * NCH + c) * 256 + ch];
    lru_wave<true>(F, l, blk, row0, 64, c == 0 ? 0 : 1, nullptr, hst, aprod);
    if (c == NCH - 1) {
        F.out[O_PLRU + ((size_t)l * NB + b) * 256 + ch] = hst;
#pragma unroll
        for (int j = 0; j < 3; ++j) F.out[O_PLRUC + ((size_t)l * NB + b) * 768 + j * 256 + ch] = bf2f(proj[(size_t)(row0 + 61 + j) * NPROJ + 2304 + ch]);
    }
}

__device__ __forceinline__ int t5_bucket(int n) {
    if (n < 16) return n;
    const int v = 16 + (int)(__log2f((float)n * (1.0f / 16.0f)) * (16.0f / 3.0f));
    return v < 31 ? v : 31;
}
template <bool SAMPLE>
__device__ __forceinline__ void swa_item(Frame& F, int l, int it) {
#ifdef SKIP_SWA
    return;
#endif
    constexpr int NQ = SAMPLE ? 8 : 32, R = 2 * NQ, SUBS = 512 / R, NK = SAMPLE ? 136 : 160, KPS = (NK + SUBS - 1) / SUBS, OFF = SAMPLE ? 128 : 127, DPT = 64 / SUBS;
    constexpr int KS = 68, PS = 161;
    LAS float* Kl = (LAS float*)F.lds; LAS float* Vl = Kl + 160 * KS; LAS float* Pl = Vl + 160 * KS; LAS float* Bl = Pl + 64 * PS;
    const int tid = F.tid; const bf16* proj = PROJ(F);
    int b, kvh, t0, seqrow0;
    if (SAMPLE) { b = it >> 1; kvh = it & 1; t0 = 0; seqrow0 = MP + b * SL; }
    else { b = it / 128; kvh = (it / 64) & 1; t0 = (it % 64) * 32; seqrow0 = b * SEQ; }
    if (tid < 256) { const int qh = tid >> 7, df = tid & 127; Bl[tid] = PIN(I_RELB)[t5_bucket(df) * 4 + kvh * 2 + qh]; }
#pragma unroll
    for (int e = tid; e < NK * 8; e += 512) {
        const int j = e >> 3, sg = e & 7;
        f32x4 k0 = {0.f, 0.f, 0.f, 0.f}, k1 = k0, v0 = k0, v1 = k0;
        if (SAMPLE && j < 128) {
            const size_t o = ((((size_t)l * SB + b) * 128 + j) * 2 + kvh) * 64 + sg * 8;
            k0 = __builtin_nontemporal_load((const f32x4*)(PIN(I_CK) + o)); k1 = __builtin_nontemporal_load((const f32x4*)(PIN(I_CK) + o + 4)); v0 = __builtin_nontemporal_load((const f32x4*)(PIN(I_CV) + o)); v1 = __builtin_nontemporal_load((const f32x4*)(PIN(I_CV) + o + 4));
        } else {
            const int kp = SAMPLE ? (j - 128) : (t0 - 127 + j);
            if (kp >= 0 && kp < (SAMPLE ? SL : t0 + NQ)) {
                const bf16* p = proj + (size_t)(seqrow0 + kp) * NPROJ + kvh * 64 + sg * 8;
                const v4u ku = *(const v4u*)(p + 1024), vu = *(const v4u*)(p + 1152);
                k0 = (f32x4){bflo(ku.x), bfhi(ku.x), bflo(ku.y), bfhi(ku.y)}; k1 = (f32x4){bflo(ku.z), bfhi(ku.z), bflo(ku.w), bfhi(ku.w)};
                v0 = (f32x4){bflo(vu.x), bfhi(vu.x), bflo(vu.y), bfhi(vu.y)}; v1 = (f32x4){bflo(vu.z), bfhi(vu.z), bflo(vu.w), bfhi(vu.w)};
            }
        }
        *(LAS f32x4*)(Kl + j * KS + sg * 8) = k0; *(LAS f32x4*)(Kl + j * KS + sg * 8 + 4) = k1;
        *(LAS f32x4*)(Vl + j * KS + sg * 8) = v0; *(LAS f32x4*)(Vl + j * KS + sg * 8 + 4) = v1;
    }
    const int r = tid / SUBS, sub = tid % SUBS, qh = r / NQ, tq = r % NQ, head = kvh * 2 + qh;
    const int qrow = seqrow0 + t0 + tq;
    float q[64];
    { const bf16* p = proj + (size_t)qrow * NPROJ + 768 + head * 64;
#pragma unroll
      for (int i = 0; i < 8; ++i) { const v4u u = *(const v4u*)(p + i * 8);
          q[i * 8 + 0] = bflo(u.x) * 0.125f; q[i * 8 + 1] = bfhi(u.x) * 0.125f; q[i * 8 + 2] = bflo(u.y) * 0.125f; q[i * 8 + 3] = bfhi(u.y) * 0.125f;
          q[i * 8 + 4] = bflo(u.z) * 0.125f; q[i * 8 + 5] = bfhi(u.z) * 0.125f; q[i * 8 + 6] = bflo(u.w) * 0.125f; q[i * 8 + 7] = bfhi(u.w) * 0.125f; } }
    const float sink = PIN(I_SINK)[l * 4 + head];
    __syncthreads();
    float s[KPS]; float mx = sink;
#pragma unroll
    for (int i = 0; i < KPS; ++i) {
        const int j = sub + SUBS * i; const int jj = j < NK ? j : NK - 1;
        const LAS float* kr = Kl + jj * KS;
        float a0 = 0.f, a1 = 0.f;
#pragma unroll
        for (int d = 0; d < 64; d += 4) { const f32x4 kv = *(const LAS f32x4*)(kr + d); a0 += q[d] * kv.x + q[d + 2] * kv.z; a1 += q[d + 1] * kv.y + q[d + 3] * kv.w; }
        const int df = tq + OFF - j; const int kp = SAMPLE ? 0 : (t0 - 127 + j);
        const bool valid = (j < NK) && (df >= 0) && (df < 128) && (kp >= 0);
        s[i] = valid ? (a0 + a1) + Bl[qh * 128 + (df & 127)] : -INFINITY;
        mx = fmaxf(mx, s[i]);
    }
#pragma unroll
    for (int o = 1; o < SUBS; o <<= 1) mx = fmaxf(mx, __shfl_xor(mx, o));
    float lsum = 0.f;
#pragma unroll
    for (int i = 0; i < KPS; ++i) { const int j = sub + SUBS * i; const float p = __expf(s[i] - mx); lsum += p; if (j < NK) Pl[r * PS + j] = p; }
#pragma unroll
    for (int o = 1; o < SUBS; o <<= 1) lsum += __shfl_xor(lsum, o);
    const float inv = 1.0f / (lsum + __expf(sink - mx));
    __syncthreads();
    float acc[DPT];
#pragma unroll
    for (int d = 0; d < DPT; ++d) acc[d] = 0.f;
#pragma unroll 8
    for (int j = 0; j < NK; ++j) {
        const float p = Pl[r * PS + j]; const LAS float* vr = Vl + j * KS + sub * DPT;
#pragma unroll
        for (int d = 0; d < DPT; ++d) acc[d] += p * vr[d];
    }
    bf16* mo = (bf16*)(F.ws + WS_MIX) + (size_t)qrow * D + 256 + head * 64 + sub * DPT;
#pragma unroll
    for (int d = 0; d < DPT; d += 2) *(unsigned*)(mo + d) = pk2(acc[d] * inv, acc[d + 1] * inv);
    if (SAMPLE) {
#pragma unroll
        for (int e = tid; e < 128 * 16; e += 512) { const int w = e >> 4, sg = e & 15, j = w + 8;
            const size_t o = ((((size_t)l * SB + b) * 128 + w) * 2 + kvh) * 64 + sg * 4;
            __builtin_nontemporal_store(*(const LAS f32x4*)(Kl + j * KS + sg * 4), (f32x4*)(F.out + O_SK + o)); __builtin_nontemporal_store(*(const LAS f32x4*)(Vl + j * KS + sg * 4), (f32x4*)(F.out + O_SV + o)); }
    } else if (t0 == SEQ - 32) {
        for (int e = tid; e < 128 * 16; e += 512) { const int w = e >> 4, sg = e & 15, j = w + 31;
            const size_t o = ((((size_t)l * NB + b) * 128 + w) * 2 + kvh) * 64 + sg * 4;
            *(f32x4*)(F.out + O_PK + o) = *(const LAS f32x4*)(Kl + j * KS + sg * 4); *(f32x4*)(F.out + O_PV + o) = *(const LAS f32x4*)(Vl + j * KS + sg * 4); }
    }
    __syncthreads();
}

template <class T> __device__ __forceinline__ T* launder_ptr(T* p) {
    unsigned long long v = (unsigned long long)p; unsigned lo = (unsigned)v, hi = (unsigned)(v >> 32);
    asm volatile("" : "+v"(lo), "+v"(hi));
    lo = (unsigned)__builtin_amdgcn_readfirstlane((int)lo); hi = (unsigned)__builtin_amdgcn_readfirstlane((int)hi);
    return (T*)(GAS T*)(((unsigned long long)hi << 32) | lo);
}
#define OPAQUE_TID(Fx) do { int t_ = (Fx).tid; asm volatile("" : "+v"(t_)); (Fx).tid = t_; (Fx).lane = t_ & 63; } while (0)
typedef float f32x16 __attribute__((ext_vector_type(16)));
constexpr int LDP = 72;
constexpr int OPB = 64 * LDP * 2;
__device__ __forceinline__ void mma64(f32x16& acc, const LAS bf16* A, const LAS bf16* B, int lane) {
    const int r = lane & 31, hq = lane >> 5;
    const LAS bf16* pa = A + r * LDP + hq * 8; const LAS bf16* pb = B + r * LDP + hq * 8;
#pragma unroll
    for (int ks = 0; ks < 4; ++ks) {
        const bf16x8 a = *(const LAS bf16x8*)(pa + ks * 16), b = *(const LAS bf16x8*)(pb + ks * 16);
        acc = __builtin_amdgcn_mfma_f32_32x32x16_bf16(a, b, acc, 0, 0, 0);
    }
}
__device__ __forceinline__ int acc_row(int i, int hq) { return (i & 3) + 8 * (i >> 2) + 4 * hq; }
__device__ __forceinline__ float incl_scan64(float x, int lane) {
#pragma unroll
    for (int o = 1; o < 64; o <<= 1) { const float y = __shfl_up(x, o); if (lane >= o) x += y; }
    return x;
}
#define F32X16_ZERO (f32x16){0.f,0.f,0.f,0.f,0.f,0.f,0.f,0.f,0.f,0.f,0.f,0.f,0.f,0.f,0.f,0.f}

constexpr int SSD_F32_OFF = 129024;
__device__ __forceinline__ void ssd_chunk_scan(Frame& F, int l, int row0, LAS float* ACUM, LAS float* DTl) {
    if (F.wave < 4) {
        const int h = F.wave, t = F.lane;
        const float dt = ((const float*)(F.ws + WS_DT))[(size_t)(row0 + t) * 4 + h];
        const float A = -__expf(PIN(I_SALOG)[l * 4 + h]);
        ACUM[h * 64 + t] = incl_scan64(dt * A, t); DTl[h * 64 + t] = dt;
    }
}
template <int NCHK, int RP, class SrcCol>
__device__ __forceinline__ void ssd_raw_load(Frame& F, int row0, bool first, LAS unsigned* RAWd, SrcCol srccol) {
    const bf16* proj = PROJ(F);
    for (int e = F.tid; e < 67 * NCHK; e += 512) {
        const int rr = e / NCHK, ck = e % NCHK;
        v4u u = {0u, 0u, 0u, 0u};
        if (!(first && rr < 3)) u = *(const v4u*)(proj + (size_t)(row0 - 3 + rr) * NPROJ + srccol(ck));
        LAS unsigned* d = RAWd + rr * (RP / 2) + ck * 4;
        d[0] = u.x; d[1] = u.y; d[2] = u.z; d[3] = u.w;
    }
}
__device__ __forceinline__ void ssd_mfma_p1(Frame& F, int l, int it) {
    const int b = it >> 5, c = it & 31, row0 = b * SEQ + c * 64, lane = F.lane, w = F.wave;
    constexpr int RP = 386;
    LAS bf16* RAW = (LAS bf16*)F.lds; LAS bf16* XT = (LAS bf16*)(F.lds + 52224); LAS bf16* BT = (LAS bf16*)(F.lds + 52224 + 4 * OPB);
    LAS float* ACUM = (LAS float*)(F.lds + SSD_F32_OFF); LAS float* DTl = ACUM + 256;
    const float* cw = PIN(I_SCW) + (size_t)l * 4 * 512; const float* cb = PIN(I_SCB) + (size_t)l * 512;
    ssd_chunk_scan(F, l, row0, ACUM, DTl);
    ssd_raw_load<48, RP>(F, row0, c == 0, (LAS unsigned*)RAW, [](int ck) { return ck < 32 ? 256 + ck * 8 : 512 + (ck - 32) * 8; });
    __syncthreads();
    {
        const int t = lane, h = w >> 1;
        const float sc = DTl[h * 64 + t] * __expf(ACUM[h * 64 + 63] - ACUM[h * 64 + t]);
#pragma unroll
        for (int j = 0; j < 32; ++j) {
            const int ch = w * 32 + j, p = ch & 63;
            const float v = cb[ch] + cw[ch] * bf2f(RAW[t * RP + ch]) + cw[512 + ch] * bf2f(RAW[(t + 1) * RP + ch]) + cw[1024 + ch] * bf2f(RAW[(t + 2) * RP + ch]) + cw[1536 + ch] * bf2f(RAW[(t + 3) * RP + ch]);
            XT[h * (64 * LDP) + p * LDP + t] = f2bf_s(siluf_(v) * sc);
        }
#pragma unroll 16
        for (int j = 0; j < 16; ++j) {
            const int cn = w * 16 + j, g = cn >> 6, n = cn & 63, ch = 256 + cn;
            const float v = cb[ch] + cw[ch] * bf2f(RAW[t * RP + ch]) + cw[512 + ch] * bf2f(RAW[(t + 1) * RP + ch]) + cw[1024 + ch] * bf2f(RAW[(t + 2) * RP + ch]) + cw[1536 + ch] * bf2f(RAW[(t + 3) * RP + ch]);
            BT[g * (64 * LDP) + n * LDP + t] = f2bf_s(siluf_(v));
        }
    }
    __syncthreads();
    {
        const int h = w >> 1, mi = w & 1, g = h >> 1, r = lane & 31, hq = lane >> 5;
        bf16* so = (bf16*)(F.ws + WS_SSDLOC) + (size_t)((b * 4 + h) * NCH + c) * 4096;
#pragma unroll
        for (int ni = 0; ni < 2; ++ni) {
            f32x16 acc = F32X16_ZERO;
            mma64(acc, XT + h * (64 * LDP) + mi * 32 * LDP, BT + g * (64 * LDP) + ni * 32 * LDP, lane);
#pragma unroll
            for (int i = 0; i < 16; ++i) so[(mi * 32 + acc_row(i, hq)) * 64 + ni * 32 + r] = f2bf_s(acc[i]);
        }
        if (w < 4 && lane == 0) ((float*)(F.ws + WS_SMALL))[(b * 4 + w) * NCH + c] = __expf(ACUM[w * 64 + 63]);
    }
    if (c == NCH - 1) {
        const bf16* proj = PROJ(F); float* dst = F.out + O_PSSMC + ((size_t)l * NB + b) * 1536;
#pragma unroll
        for (int j = 0; j < 3; ++j) dst[j * 512 + F.tid] = bf2f(proj[(size_t)(row0 + 61 + j) * NPROJ + 256 + F.tid]);
    }
    __syncthreads();
}
struct HgPre { unsigned short frw[16], qrw[16], vrw[16]; v4u sinr[2]; };
__device__ __forceinline__ void hgrn_p2_load(Frame& F, int it, HgPre& P);
template <bool HOOK = false>
__device__ __forceinline__ void ssd_mfma_p2(Frame& F, int l, int it, HgPre* nextpre = nullptr) {
    const int b = it >> 5, c = it & 31, row0 = b * SEQ + c * 64, lane = F.lane, w = F.wave, tid = F.tid;
    constexpr int RP = 258;
    LAS bf16* Cn = (LAS bf16*)F.lds; LAS bf16* Bn = (LAS bf16*)(F.lds + 2 * OPB); LAS bf16* XT = (LAS bf16*)(F.lds + 4 * OPB);
    LAS bf16* RAW = (LAS bf16*)(F.lds + 8 * OPB); LAS bf16* Gm = RAW;
    LAS float* ACUM = (LAS float*)(F.lds + SSD_F32_OFF); LAS float* DTl = ACUM + 256; LAS float* ssq = (LAS float*)(F.lds + SSQ_LDS_OFF);
    const float* cw = PIN(I_SCW) + (size_t)l * 4 * 512; const float* cb = PIN(I_SCB) + (size_t)l * 512;
    const bf16* sin_g = (const bf16*)(F.ws + WS_SSDLOC) + (size_t)(b * 4 * NCH + c) * 4096;
    ssd_chunk_scan(F, l, row0, ACUM, DTl);
    if (tid < 64) ssq[tid] = 0.f;
    const int h = w >> 1, mi = w & 1, g = h >> 1, r = lane & 31, hq = lane >> 5;
    const bf16* proj = PROJ(F);
    unsigned short zr[2][16];
#pragma unroll
    for (int pi = 0; pi < 2; ++pi)
#pragma unroll
        for (int i = 0; i < 16; ++i) zr[pi][i] = proj[(size_t)(row0 + mi * 32 + acc_row(i, hq)) * NPROJ + h * 64 + pi * 32 + r];
    v4u sinr[4];
#pragma unroll
    for (int k = 0; k < 4; ++k) { const int e = tid + 512 * k, hh = e >> 9, p = (e >> 3) & 63, n0 = (e & 7) * 8;
        sinr[k] = *(const v4u*)(sin_g + (size_t)hh * NCH * 4096 + p * 64 + n0); }
#define SSD_SIN_STORE(k) do { const int e_ = tid + 512 * (k), hh_ = e_ >> 9, p_ = (e_ >> 3) & 63, n0_ = (e_ & 7) * 8; \
        *(LAS v4u*)(F.lds + (hh_ < 2 ? (2 + hh_) * OPB : 12 * OPB + (hh_ - 2) * OPB) + (p_ * LDP + n0_) * 2) = sinr[k]; } while (0)
    SSD_SIN_STORE(2); SSD_SIN_STORE(3);
    {
        ssd_raw_load<32, RP>(F, row0, c == 0, (LAS unsigned*)RAW, [](int ck) { return ck < 16 ? 256 + ck * 8 : (ck < 24 ? 512 + (ck - 16) * 8 : 640 + (ck - 24) * 8); });
        __syncthreads();
    }
    v4u rawr[5];
#pragma unroll
    for (int k = 0; k < 5; ++k) { const int e = tid + 512 * k, rr = e >> 5, ck = e & 31;
        rawr[k] = (v4u){0u, 0u, 0u, 0u};
        if (e < 67 * 32 && !(c == 0 && rr < 3)) rawr[k] = *(const v4u*)(proj + (size_t)(row0 - 3 + rr) * NPROJ + (ck < 16 ? 256 + 128 + ck * 8 : (ck < 24 ? 512 + 64 + (ck - 16) * 8 : 640 + 64 + (ck - 24) * 8))); }
#pragma unroll 1
    for (int gg = 0; gg < 2; ++gg) {
        if (gg == 1) {
#pragma unroll
            for (int k = 0; k < 5; ++k) { const int e = tid + 512 * k, rr = e >> 5, ck = e & 31;
                if (e < 67 * 32) { LAS unsigned* d = (LAS unsigned*)RAW + rr * (RP / 2) + ck * 4; d[0] = rawr[k].x; d[1] = rawr[k].y; d[2] = rawr[k].z; d[3] = rawr[k].w; } }
            __syncthreads();
        }
        {
            const int t = lane;
#pragma unroll 16
            for (int j = 0; j < 16; ++j) {
                const int cr = w * 16 + j, ch = gg * 128 + cr, hx = ch >> 6, p = ch & 63;
                const float v = cb[ch] + cw[ch] * bf2f(RAW[t * RP + cr]) + cw[512 + ch] * bf2f(RAW[(t + 1) * RP + cr]) + cw[1024 + ch] * bf2f(RAW[(t + 2) * RP + cr]) + cw[1536 + ch] * bf2f(RAW[(t + 3) * RP + cr]);
                XT[hx * (64 * LDP) + p * LDP + t] = f2bf_s(siluf_(v));
            }
        }
        {
            const int n = lane, chB = 256 + gg * 64 + n, chC = 384 + gg * 64 + n;
            const float b0 = cw[chB], b1 = cw[512 + chB], b2 = cw[1024 + chB], b3 = cw[1536 + chB], bb = cb[chB];
            const float c0 = cw[chC], c1 = cw[512 + chC], c2 = cw[1024 + chC], c3 = cw[1536 + chC], cc = cb[chC];
#pragma unroll 16
            for (int j = 0; j < 8; ++j) {
                const int t = w * 8 + j;
                const float vb = bb + b0 * bf2f(RAW[t * RP + 128 + n]) + b1 * bf2f(RAW[(t + 1) * RP + 128 + n]) + b2 * bf2f(RAW[(t + 2) * RP + 128 + n]) + b3 * bf2f(RAW[(t + 3) * RP + 128 + n]);
                const float vc = cc + c0 * bf2f(RAW[t * RP + 192 + n]) + c1 * bf2f(RAW[(t + 1) * RP + 192 + n]) + c2 * bf2f(RAW[(t + 2) * RP + 192 + n]) + c3 * bf2f(RAW[(t + 3) * RP + 192 + n]);
                Bn[gg * (64 * LDP) + t * LDP + n] = f2bf_s(siluf_(vb)); Cn[gg * (64 * LDP) + t * LDP + n] = f2bf_s(siluf_(vc));
            }
        }
        __syncthreads();
    }
    {
#pragma unroll
        for (int ni = 0; ni < 2; ++ni) {
            f32x16 acc = F32X16_ZERO;
            if (ni <= mi) mma64(acc, Cn + g * (64 * LDP) + mi * 32 * LDP, Bn + g * (64 * LDP) + ni * 32 * LDP, lane);
            const int s = ni * 32 + r; const float acs = ACUM[h * 64 + s], dts = DTl[h * 64 + s];
#pragma unroll
            for (int i = 0; i < 16; ++i) {
                const int t = mi * 32 + acc_row(i, hq);
                const float v = (ni <= mi && s <= t) ? acc[i] * __expf(ACUM[h * 64 + t] - acs) * dts : 0.f;
                Gm[h * (64 * LDP) + t * LDP + s] = f2bf_s(v);
            }
        }
    }
    __syncthreads();
    SSD_SIN_STORE(0); SSD_SIN_STORE(1);
#undef SSD_SIN_STORE
    __syncthreads();
    float yg[2][16];
    {
        const LAS bf16* Sin = (const LAS bf16*)(F.lds + (h < 2 ? (2 + h) * OPB : 12 * OPB + (h - 2) * OPB));
        const float Dh = PIN(I_SD)[l * 4 + h];
        float eac[16];
#pragma unroll
        for (int i = 0; i < 16; ++i) eac[i] = __expf(ACUM[h * 64 + mi * 32 + acc_row(i, hq)]);
#pragma unroll
        for (int pi = 0; pi < 2; ++pi) {
            f32x16 ay = F32X16_ZERO, ao = F32X16_ZERO;
            mma64(ay, Gm + h * (64 * LDP) + mi * 32 * LDP, XT + h * (64 * LDP) + pi * 32 * LDP, lane);
            mma64(ao, Cn + g * (64 * LDP) + mi * 32 * LDP, Sin + pi * 32 * LDP, lane);
            const int p = pi * 32 + r;
#pragma unroll
            for (int i = 0; i < 16; ++i) {
                const int t = mi * 32 + acc_row(i, hq);
                const float xs = bf2f(XT[h * (64 * LDP) + p * LDP + t]);
                const float z = bf2f(zr[pi][i]);
                yg[pi][i] = (ay[i] + ao[i] * eac[i] + Dh * xs) * siluf_(z);
            }
        }
#pragma unroll
        for (int i = 0; i < 16; ++i) {
            float q = yg[0][i] * yg[0][i] + yg[1][i] * yg[1][i];
            q = half32_sum_hi(q);
            if (r == 31) __hip_atomic_fetch_add(ssq + mi * 32 + acc_row(i, hq), q, __ATOMIC_RELAXED, __HIP_MEMORY_SCOPE_WORKGROUP);
        }
    }
    if (HOOK) hgrn_p2_load(F, it, *nextpre);
    __syncthreads();
    {
        bf16* mix = (bf16*)(F.ws + WS_MIX);
#pragma unroll
        for (int pi = 0; pi < 2; ++pi) {
            const int ch = h * 64 + pi * 32 + r; const float nw = PIN(I_SNW)[l * 256 + ch];
#pragma unroll
            for (int i = 0; i < 16; ++i) {
                const int t = mi * 32 + acc_row(i, hq);
                const float rs = rsqf_(ssq[t] * (1.0f / 256.0f) + EPS);
                mix[(size_t)(row0 + t) * D + ch] = f2bf_s(yg[pi][i] * rs * nw);
            }
        }
    }
    __syncthreads();
}

constexpr int HG_TOT_OFF = 12 * OPB, HG_SSQ_OFF = HG_TOT_OFF + 2048;
template <bool PASS2>
__device__ __forceinline__ void hgrn_elem(Frame& F, int l, int row0, int hp) {
    const int w = F.wave, lane = F.lane, hl = w >> 2, seg = w & 3, h = hp * 2 + hl, ch = h * 64 + lane;
    const bf16* proj = PROJ(F);
    LAS float* TOT = (LAS float*)(F.lds + HG_TOT_OFF);
    const float lbk = (l == 0) ? 0.f : sigmoidf_(PIN(I_HLB)[256 + ch] - PIN(I_HLB)[ch]);
    float fr[16], bc[16]; unsigned short qraw[16];
#pragma unroll
    for (int i = 0; i < 16; ++i) { fr[i] = bf2f(proj[(size_t)(row0 + seg * 16 + i) * NPROJ + 1536 + ch]); qraw[i] = PASS2 ? proj[(size_t)(row0 + seg * 16 + i) * NPROJ + 1280 + ch] : (unsigned short)0; }
    float run = 0.f;
#pragma unroll
    for (int i = 0; i < 16; ++i) { const float f = lbk + (1.0f - lbk) * sigmoidf_(fr[i]); run += __logf(f); bc[i] = run; }
    TOT[(hl * 4 + seg) * 64 + lane] = run;
    __syncthreads();
    const float t0 = TOT[(hl * 4 + 0) * 64 + lane], t1 = TOT[(hl * 4 + 1) * 64 + lane], t2 = TOT[(hl * 4 + 2) * 64 + lane], t3 = TOT[(hl * 4 + 3) * 64 + lane];
    const float off = seg == 0 ? 0.f : seg == 1 ? t0 : seg == 2 ? t0 + t1 : t0 + t1 + t2;
    const float ref = t0 + t1, tot = (t0 + t1) + (t2 + t3);
    if (PASS2) {
        LAS bf16* QT = (LAS bf16*)(F.lds + (hl * 6 + 0) * OPB); LAS bf16* KT = (LAS bf16*)(F.lds + (hl * 6 + 1) * OPB); LAS bf16* QP = (LAS bf16*)(F.lds + (hl * 6 + 2) * OPB);
#pragma unroll
        for (int i = 0; i < 16; ++i) {
            const int t = seg * 16 + i; const float b_ = bc[i] + off;
            const float q = bf2f(qraw[i]);
            const float kk = (1.0f - lbk) / (1.0f + __expf(fr[i]));
            QT[t * LDP + lane] = f2bf_s(q * __expf(b_ - ref)); KT[t * LDP + lane] = f2bf_s(kk * __expf(ref - b_)); QP[t * LDP + lane] = f2bf_s(q * __expf(b_));
        }
    } else {
        LAS bf16* KPT = (LAS bf16*)(F.lds + (hl * 2 + 1) * OPB);
#pragma unroll
        for (int i = 0; i < 16; ++i) {
            const int t = seg * 16 + i; const float b_ = bc[i] + off;
            const float kk = (1.0f - lbk) / (1.0f + __expf(fr[i]));
            KPT[lane * LDP + t] = f2bf_s(kk * __expf(tot - b_));
        }
    }
}
__device__ __forceinline__ void hgrn_vt(Frame& F, int row0, int hp, int tile_stride, int tile_off) {
    const int w = F.wave, lane = F.lane, hl = w >> 2, seg = w & 3, h = hp * 2 + hl, ch = h * 64 + lane;
    const bf16* proj = PROJ(F);
    LAS bf16* VT = (LAS bf16*)(F.lds + (hl * tile_stride + tile_off) * OPB);
#pragma unroll
    for (int i = 0; i < 16; ++i) { const int t = seg * 16 + i; VT[lane * LDP + t] = proj[(size_t)(row0 + t) * NPROJ + 1792 + ch]; }
}
__device__ __forceinline__ void hgrn_p1_load(Frame& F, int it, unsigned short (&frw)[32], unsigned short (&vrw)[32]) {
    const int b = it >> 5, c = it & 31, row0 = b * SEQ + c * 64, h = F.wave >> 1, th = F.wave & 1, ch = h * 64 + F.lane;
    const bf16* proj = PROJ(F);
#pragma unroll
    for (int i = 0; i < 32; ++i) { const bf16* p = proj + (size_t)(row0 + th * 32 + i) * NPROJ + ch; frw[i] = p[1536]; vrw[i] = p[1792]; }
}
__device__ __forceinline__ void hgrn_mfma_p1(Frame& F, int l, int it, const unsigned short (&frw)[32], const unsigned short (&vrw)[32]) {
    const int b = it >> 5, c = it & 31, row0 = b * SEQ + c * 64, lane = F.lane, w = F.wave;
    const int h = w >> 1, th = w & 1, ch = h * 64 + lane;
    const bf16* proj = PROJ(F);
    LAS float* TOT = (LAS float*)(F.lds + HG_TOT_OFF);
    LAS bf16* VT = (LAS bf16*)(F.lds + (h * 2 + 0) * OPB); LAS bf16* KPT = (LAS bf16*)(F.lds + (h * 2 + 1) * OPB);
    const float lbk = (l == 0) ? 0.f : sigmoidf_(PIN(I_HLB)[256 + ch] - PIN(I_HLB)[ch]);
    float fr[32]; unsigned short vr[32];
#pragma unroll
    for (int i = 0; i < 32; ++i) { fr[i] = bf2f(frw[i]); vr[i] = vrw[i]; }
    float bc[32]; float run = 0.f;
#pragma unroll
    for (int i = 0; i < 32; ++i) { const float sg = sigmoidf_(fr[i]), f = lbk + (1.0f - lbk) * sg; run += __logf(f); bc[i] = run; fr[i] = 1.0f - sg; }
    TOT[(h * 2 + th) * 64 + lane] = run;
#pragma unroll
    for (int i = 0; i < 32; ++i) VT[lane * LDP + th * 32 + i] = vr[i];
    __syncthreads();
    const float t0 = TOT[(h * 2 + 0) * 64 + lane], t1 = TOT[(h * 2 + 1) * 64 + lane], tot = t0 + t1, off = th ? t0 : 0.f;
#pragma unroll
    for (int i = 0; i < 32; ++i) {
        const float kk = (1.0f - lbk) * fr[i];
        KPT[lane * LDP + th * 32 + i] = f2bf_s(kk * __expf(tot - (bc[i] + off)));
    }
    __syncthreads();
    {
        const int mi = th, r = lane & 31, hq = lane >> 5, sidx = (b * 4 + h) * NCH + c;
        bf16* so = (bf16*)(F.ws + WS_HGLOC) + (size_t)sidx * 4096;
#pragma unroll
        for (int ni = 0; ni < 2; ++ni) {
            f32x16 acc = F32X16_ZERO;
            mma64(acc, VT + mi * 32 * LDP, KPT + ni * 32 * LDP, lane);
#pragma unroll
            for (int i = 0; i < 16; ++i) so[(mi * 32 + acc_row(i, hq)) * 64 + ni * 32 + r] = f2bf_s(acc[i]);
        }
        if (th == 0) ((float*)(F.ws + WS_SMALL))[1024 + (size_t)sidx * 64 + lane] = __expf(tot);
    }
    __syncthreads();
}
#define HG_LOAD_INTO(P_, hp_) do { const int ch_ = ((hp_) * 2 + hl) * 64 + lane; \
        _Pragma("unroll") for (int i = 0; i < 16; ++i) { const bf16* p_ = proj + (size_t)(row0 + seg * 16 + i) * NPROJ + ch_; (P_).frw[i] = p_[1536]; (P_).qrw[i] = p_[1280]; (P_).vrw[i] = p_[1792]; } \
        _Pragma("unroll") for (int k = 0; k < 2; ++k) { const int e_ = tid + 512 * k, hl_ = e_ >> 9, v_ = (e_ >> 3) & 63, k0_ = (e_ & 7) * 8; \
            (P_).sinr[k] = *(const v4u*)((const bf16*)(F.ws + WS_HGLOC) + (size_t)((b * 4 + (hp_) * 2 + hl_) * NCH + c) * 4096 + v_ * 64 + k0_); } } while (0)
__device__ __forceinline__ void hgrn_p2_load(Frame& F, int it, HgPre& P) {
    const int b = it >> 5, c = it & 31, row0 = b * SEQ + c * 64, lane = F.lane, w = F.wave, tid = F.tid, hl = w >> 2, seg = w & 3;
    const bf16* proj = PROJ(F);
    HG_LOAD_INTO(P, 0);
}
template <bool PRELOADED = false>
__device__ __forceinline__ void hgrn_mfma_p2(Frame& F, int l, int it, HgPre* pre = nullptr) {
    const int b = it >> 5, c = it & 31, row0 = b * SEQ + c * 64, lane = F.lane, w = F.wave, tid = F.tid;
    const int hl = w >> 2, seg = w & 3, mi = (w >> 1) & 1, ni = w & 1, r = lane & 31, hq = lane >> 5;
    const bf16* proj = PROJ(F); bf16* mix = (bf16*)(F.ws + WS_MIX);
    LAS float* ssq = (LAS float*)(F.lds + HG_SSQ_OFF); LAS float* TOT = (LAS float*)(F.lds + HG_TOT_OFF);
    const LAS bf16* QT = (const LAS bf16*)(F.lds + (hl * 6 + 0) * OPB); const LAS bf16* KT = (const LAS bf16*)(F.lds + (hl * 6 + 1) * OPB);
    const LAS bf16* QP = (const LAS bf16*)(F.lds + (hl * 6 + 2) * OPB); LAS bf16* VT = (LAS bf16*)(F.lds + (hl * 6 + 3) * OPB);
    const LAS bf16* SIN = (const LAS bf16*)(F.lds + (hl * 6 + 4) * OPB); LAS bf16* AM = (LAS bf16*)(F.lds + (hl * 6 + 5) * OPB);
    HgPre R;
    if (PRELOADED) R = *pre; else HG_LOAD_INTO(R, 0);
#pragma unroll
    for (int hp = 0; hp < 2; ++hp) {
        const int h = hp * 2 + hl, ch = h * 64 + lane;
        if (tid < 128) ssq[tid] = 0.f;
        const float lbk = (l == 0) ? 0.f : sigmoidf_(PIN(I_HLB)[256 + ch] - PIN(I_HLB)[ch]);
        float fr[16], bc[16], qv[16];
        {
            float run = 0.f;
#pragma unroll
            for (int i = 0; i < 16; ++i) { qv[i] = bf2f(R.qrw[i]); const float sg = sigmoidf_(bf2f(R.frw[i])), f = lbk + (1.0f - lbk) * sg; fr[i] = 1.0f - sg; run += __logf(f); bc[i] = run; VT[lane * LDP + seg * 16 + i] = R.vrw[i]; }
            TOT[(hl * 4 + seg) * 64 + lane] = run;
#pragma unroll
            for (int k = 0; k < 2; ++k) { const int e_ = tid + 512 * k, hl_ = e_ >> 9, v_ = (e_ >> 3) & 63, k0_ = (e_ & 7) * 8;
                *(LAS v4u*)(F.lds + (hl_ * 6 + 4) * OPB + (v_ * LDP + k0_) * 2) = R.sinr[k]; }
        }
        if (hp == 0) HG_LOAD_INTO(R, 1);
        __syncthreads();
        {
            const float t0 = TOT[(hl * 4 + 0) * 64 + lane], t1 = TOT[(hl * 4 + 1) * 64 + lane], t2 = TOT[(hl * 4 + 2) * 64 + lane];
            const float off = seg == 0 ? 0.f : seg == 1 ? t0 : seg == 2 ? t0 + t1 : t0 + t1 + t2, ref = t0 + t1, eref = __expf(ref);
            LAS bf16* QTw = (LAS bf16*)QT; LAS bf16* KTw = (LAS bf16*)KT; LAS bf16* QPw = (LAS bf16*)QP;
#pragma unroll
            for (int i = 0; i < 16; ++i) {
                const int t = seg * 16 + i; const float b_ = bc[i] + off, kk = (1.0f - lbk) * fr[i], e1 = __expf(b_ - ref), qe = qv[i] * e1;
                QTw[t * LDP + lane] = f2bf_s(qe); KTw[t * LDP + lane] = f2bf_s(kk * rcpf_(e1)); QPw[t * LDP + lane] = f2bf_s(qe * eref);
            }
        }
        __syncthreads();
        unsigned short graw[16];
#pragma unroll
        for (int i = 0; i < 16; ++i) graw[i] = proj[(size_t)(row0 + mi * 32 + acc_row(i, hq)) * NPROJ + 2048 + h * 64 + ni * 32 + r];
        {
            f32x16 acc = F32X16_ZERO;
            if (ni <= mi) mma64(acc, QT + mi * 32 * LDP, KT + ni * 32 * LDP, lane);
            const int sidx = ni * 32 + r;
#pragma unroll
            for (int i = 0; i < 16; ++i) { const int t = mi * 32 + acc_row(i, hq); AM[t * LDP + sidx] = f2bf_s((ni <= mi && sidx <= t) ? acc[i] : 0.f); }
        }
        __syncthreads();
        f32x16 o = F32X16_ZERO;
        mma64(o, AM + mi * 32 * LDP, VT + ni * 32 * LDP, lane);
        mma64(o, QP + mi * 32 * LDP, SIN + ni * 32 * LDP, lane);
#pragma unroll
        for (int i = 0; i < 16; ++i) {
            float q = o[i] * o[i];
            q = half32_sum_hi(q);
            if (r == 31) __hip_atomic_fetch_add(ssq + hl * 64 + mi * 32 + acc_row(i, hq), q, __ATOMIC_RELAXED, __HIP_MEMORY_SCOPE_WORKGROUP);
        }
        __syncthreads();
        {
            const int cho = h * 64 + ni * 32 + r; const float nw = PIN(I_HNW)[l * 256 + cho];
#pragma unroll
            for (int i = 0; i < 16; ++i) {
                const int t = mi * 32 + acc_row(i, hq);
                const float rs = rsqf_(ssq[hl * 64 + t] * (1.0f / 64.0f) + EPS);
                mix[(size_t)(row0 + t) * D + 512 + cho] = f2bf_s(o[i] * rs * nw * sigmoidf_(bf2f(graw[i])));
            }
        }
        __syncthreads();
    }
}

constexpr int LRU_RP = 258, LRU_XP = 264, LRU_XC_OFF = 36864;
__device__ __forceinline__ void lru_raw_load(Frame& F, int it, v4u (&rawr)[5]) {
    const int b = it >> 5, c = it & 31, row0 = b * SEQ + c * 64; const bf16* proj = PROJ(F);
#pragma unroll
    for (int k = 0; k < 5; ++k) { const int e = F.tid + 512 * k, rr = e >> 5, ck = e & 31;
        rawr[k] = (v4u){0u, 0u, 0u, 0u};
        if (e < 67 * 32 && !(c == 0 && rr < 3)) rawr[k] = *(const v4u*)(proj + (size_t)(row0 - 3 + rr) * NPROJ + 2304 + ck * 8); }
}
template <bool PASS2, bool PRELOADED = false>
__device__ __forceinline__ void lru_mfma(Frame& F, int l, int it, const v4u (*rawr)[5] = nullptr) {
    const int b = it >> 5, c = it & 31, row0 = b * SEQ + c * 64, lane = F.lane, w = F.wave, tid = F.tid;
    LAS bf16* RAW = (LAS bf16*)F.lds; LAS bf16* Xc = (LAS bf16*)(F.lds + LRU_XC_OFF);
    const bf16* proj = PROJ(F);
    if (PRELOADED) {
#pragma unroll
        for (int k = 0; k < 5; ++k) { const int e = tid + 512 * k, rr = e >> 5, ck = e & 31;
            if (e < 67 * 32) { LAS unsigned* d = (LAS unsigned*)RAW + rr * (LRU_RP / 2) + ck * 4; d[0] = (*rawr)[k].x; d[1] = (*rawr)[k].y; d[2] = (*rawr)[k].z; d[3] = (*rawr)[k].w; } }
    } else ssd_raw_load<32, LRU_RP>(F, row0, c == 0, (LAS unsigned*)RAW, [](int ck) { return 2304 + ck * 8; });
    __syncthreads();
    {
        const float* cw = PIN(I_LCW) + (size_t)l * 4 * 256; const float* cb = PIN(I_LCB) + (size_t)l * 256;
#pragma unroll
        for (int q = 0; q < 4; ++q) {
            const int ch = q * 64 + lane; const float w0 = cw[ch], w1 = cw[256 + ch], w2 = cw[512 + ch], w3 = cw[768 + ch], bb = cb[ch];
#pragma unroll 16
            for (int j = 0; j < 8; ++j) { const int t = w * 8 + j;
                Xc[t * LRU_XP + ch] = f2bf_s(bb + w0 * bf2f(RAW[t * LRU_RP + ch]) + w1 * bf2f(RAW[(t + 1) * LRU_RP + ch]) + w2 * bf2f(RAW[(t + 2) * LRU_RP + ch]) + w3 * bf2f(RAW[(t + 3) * LRU_RP + ch])); }
        }
    }
    __syncthreads();
    const int blk = w >> 1, ni = w & 1, r = lane & 31, hq = lane >> 5, ch = blk * 64 + ni * 32 + r;
    unsigned short graw[2][16];
    if (PASS2) {
#pragma unroll
        for (int mi = 0; mi < 2; ++mi)
#pragma unroll
            for (int i = 0; i < 16; ++i) graw[mi][i] = proj[(size_t)(row0 + mi * 32 + acc_row(i, hq)) * NPROJ + 2560 + ch];
    }
    f32x16 ar[2] = {F32X16_ZERO, F32X16_ZERO}, ai[2] = {F32X16_ZERO, F32X16_ZERO};
    {
        const bf16* wt = (const bf16*)(F.ws + WS_LWT) + (size_t)(l * 2 * 4 + blk) * 4096 + (ni * 32 + r) * 64 + hq * 8;
#pragma unroll
        for (int ks = 0; ks < 4; ++ks) {
            const bf16x8 br = *(const bf16x8*)(wt + ks * 16), bi = *(const bf16x8*)(wt + 4 * 4096 + ks * 16);
#pragma unroll
            for (int mi = 0; mi < 2; ++mi) {
                const bf16x8 a = *(const LAS bf16x8*)(Xc + (mi * 32 + r) * LRU_XP + blk * 64 + ks * 16 + hq * 8);
                ar[mi] = __builtin_amdgcn_mfma_f32_32x32x16_bf16(a, br, ar[mi], 0, 0, 0);
                ai[mi] = __builtin_amdgcn_mfma_f32_32x32x16_bf16(a, bi, ai[mi], 0, 0, 0);
            }
        }
    }
    const float ba = PIN(I_LBA)[l * 256 + ch], bx = PIN(I_LBX)[l * 256 + ch], sp = softplusf_(-PIN(I_LLAM)[l * 256 + ch]);
#pragma unroll
    for (int mi = 0; mi < 2; ++mi)
#pragma unroll
        for (int i = 0; i < 16; ++i) {
            const int t = mi * 32 + acc_row(i, hq);
            const float xc = bf2f(Xc[t * LRU_XP + ch]);
            const float log_a = -8.0f * sigmoidf_(ar[mi][i] + ba) * sp, ig = sigmoidf_(ai[mi][i] + bx);
            const float a_ = __expf(log_a), z2 = 2.0f * log_a;
            const float om = z2 > -0.25f ? -z2 * (1.0f + z2 * (0.5f + z2 * (0.16666667f + z2 * (0.041666668f + z2 * 0.008333334f)))) : 1.0f - a_ * a_;
            ar[mi][i] = a_; ai[mi][i] = __builtin_amdgcn_sqrtf(om) * (ig * xc);
        }
    float Ao[8], Uo[8], Ap[8], Up[8];
#pragma unroll
    for (int k = 0; k < 8; ++k) { const int mi = k >> 2, i0 = (k & 3) * 4;
        float A = ar[mi][i0], U = ai[mi][i0];
#pragma unroll
        for (int j = 1; j < 4; ++j) { U = U * ar[mi][i0 + j] + ai[mi][i0 + j]; A *= ar[mi][i0 + j]; }
        Ao[k] = A; Uo[k] = U; Ap[k] = __shfl_xor(A, 32); Up[k] = __shfl_xor(U, 32); }
    float* lruH = (float*)(F.ws + WS_SMALL) + 1024 + 65536; float* lruA = lruH + 65536;
    float h = PASS2 ? lruH[(size_t)(b * NCH + c) * 256 + ch] : 0.f, hs[8], as[8], atot = 1.0f;
#pragma unroll
    for (int k = 0; k < 8; ++k) {
        const float A1 = hq ? Ap[k] : Ao[k], U1 = hq ? Up[k] : Uo[k], A2 = hq ? Ao[k] : Ap[k], U2 = hq ? Uo[k] : Up[k];
        const float h1 = A1 * h + U1;
        hs[k] = hq ? h1 : h; as[k] = hq ? atot * A1 : atot;
        h = A2 * h1 + U2; atot *= A1 * A2;
    }
    if (!PASS2) {
        if (hq == 0) { lruH[(size_t)(b * NCH + c) * 256 + ch] = h; lruA[(size_t)(b * NCH + c) * 256 + ch] = atot; }
        {
            unsigned* cache = (unsigned*)(F.out + O_Y);
#pragma unroll
            for (int k = 0; k < 8; ++k) { const int mi = k >> 2, i0 = (k & 3) * 4; float hc = hs[k], ac = as[k];
#pragma unroll
                for (int j = 0; j < 4; ++j) {
                    hc = ar[mi][i0 + j] * hc + ai[mi][i0 + j]; ac *= ar[mi][i0 + j];
                    cache[(size_t)(row0 + mi * 32 + acc_row(i0 + j, hq)) * 256 + ch] = pk2(hc, ac);
                }
            }
        }
        if (c == NCH - 1 && tid < 256) {
#pragma unroll
            for (int j = 0; j < 3; ++j) F.out[O_PLRUC + ((size_t)l * NB + b) * 768 + j * 256 + tid] = bf2f(proj[(size_t)(row0 + 61 + j) * NPROJ + 2304 + tid]);
        }
    } else {
        bf16* mix = (bf16*)(F.ws + WS_MIX);
#pragma unroll
        for (int k = 0; k < 8; ++k) { const int mi = k >> 2, i0 = (k & 3) * 4; float hc = hs[k];
#pragma unroll
            for (int j = 0; j < 4; ++j) {
                hc = ar[mi][i0 + j] * hc + ai[mi][i0 + j];
                const int t = mi * 32 + acc_row(i0 + j, hq);
                const float gv = bf2f(graw[mi][i0 + j]);
                mix[(size_t)(row0 + t) * D + 768 + ch] = f2bf_s(hc * geluf_(gv));
            }
        }
    }
    __syncthreads();
}

__device__ __forceinline__ void lru_p2_cached(Frame& F, int l, int it) {
    const int b = it >> 5, c = it & 31, row0 = b * SEQ + c * 64, lane = F.lane, w = F.wave;
    const bf16* proj = PROJ(F); bf16* mix = (bf16*)(F.ws + WS_MIX);
    const unsigned* cache = (const unsigned*)(F.out + O_Y);
    const float* lruH = (const float*)(F.ws + WS_SMALL) + 1024 + 65536;
    const f32x4 hin = *(const f32x4*)(lruH + (size_t)(b * NCH + c) * 256 + lane * 4);
    v4u cv[8]; v2u gv[8];
#pragma unroll
    for (int j = 0; j < 8; ++j) { const int t = w * 8 + j;
        cv[j] = *(const v4u*)(cache + (size_t)(row0 + t) * 256 + lane * 4); gv[j] = *(const v2u*)(proj + (size_t)(row0 + t) * NPROJ + 2560 + lane * 4); }
#pragma unroll
    for (int j = 0; j < 8; ++j) { const int t = w * 8 + j;
        const float h0 = bflo(cv[j].x) + bfhi(cv[j].x) * hin.x, h1 = bflo(cv[j].y) + bfhi(cv[j].y) * hin.y, h2 = bflo(cv[j].z) + bfhi(cv[j].z) * hin.z, h3 = bflo(cv[j].w) + bfhi(cv[j].w) * hin.w;
        v2u o; o.x = pk2(h0 * geluf_(bflo(gv[j].x)), h1 * geluf_(bfhi(gv[j].x))); o.y = pk2(h2 * geluf_(bflo(gv[j].y)), h3 * geluf_(bfhi(gv[j].y)));
        *(v2u*)(mix + (size_t)(row0 + t) * D + 768 + lane * 4) = o; }
}

constexpr int SW_KOFF = 0, SW_VP = 200, SW_VOFF = 192 * LDP * 2, SW_POFF = SW_VOFF + 64 * SW_VP * 2, SW_BOFF = SW_POFF + 128 * SW_VP * 2, SW_MOFF = SW_BOFF + 1024, SW_SOFF = SW_MOFF + 1024;
__device__ __forceinline__ void swa_mfma(Frame& F, int l, int it) {
    const int b = it >> 6, kvh = (it >> 5) & 1, t0 = (it & 31) * 64, seqrow0 = b * SEQ, lane = F.lane, w = F.wave, tid = F.tid;
    const int rt = w >> 1, kh = w & 1, qh = rt >> 1, qhalf = rt & 1, head = kvh * 2 + qh, r = lane & 31, hq = lane >> 5;
    const bf16* proj = PROJ(F);
    LAS bf16* Kl = (LAS bf16*)(F.lds + SW_KOFF); LAS bf16* VT = (LAS bf16*)(F.lds + SW_VOFF); LAS bf16* Pl = (LAS bf16*)(F.lds + SW_POFF);
    LAS float* Bl = (LAS float*)(F.lds + SW_BOFF); LAS float* Ms = (LAS float*)(F.lds + SW_MOFF); LAS float* Ss = (LAS float*)(F.lds + SW_SOFF);
    bf16x8 qf[4];
    { const bf16* qp = proj + (size_t)(seqrow0 + t0 + qhalf * 32 + r) * NPROJ + 768 + head * 64 + hq * 8;
#pragma unroll
      for (int ks = 0; ks < 4; ++ks) qf[ks] = *(const bf16x8*)(qp + ks * 16); }
    if (tid < 256) { const int q2 = tid >> 7, df = tid & 127; Bl[tid] = PIN(I_RELB)[t5_bucket(df) * 4 + kvh * 2 + q2]; }
#pragma unroll
    for (int e = tid; e < 192 * 8; e += 512) {
        const int j = e >> 3, sg = e & 7, kp = t0 - 127 + j;
        v4u ku = {0u, 0u, 0u, 0u}, vu = ku;
        if (kp >= 0 && j < 191) { const bf16* p = proj + (size_t)(seqrow0 + kp) * NPROJ + kvh * 64 + sg * 8; ku = *(const v4u*)(p + 1024); vu = *(const v4u*)(p + 1152); }
        *(LAS v4u*)(Kl + j * LDP + sg * 8) = ku;
        LAS bf16* vd = VT + (sg * 8) * SW_VP + (((j >> 3) ^ sg) << 3) + (j & 7);
        vd[0] = (bf16)(vu.x & 0xffff); vd[SW_VP] = (bf16)(vu.x >> 16); vd[2 * SW_VP] = (bf16)(vu.y & 0xffff); vd[3 * SW_VP] = (bf16)(vu.y >> 16);
        vd[4 * SW_VP] = (bf16)(vu.z & 0xffff); vd[5 * SW_VP] = (bf16)(vu.z >> 16); vd[6 * SW_VP] = (bf16)(vu.w & 0xffff); vd[7 * SW_VP] = (bf16)(vu.w >> 16);
    }
    __syncthreads();
    f32x16 sc[3];
    const int tq = qhalf * 32 + r;
    const float sink = PIN(I_SINK)[l * 4 + head];
    float mx = -INFINITY;
#pragma unroll
    for (int kt = 0; kt < 3; ++kt) {
        f32x16 acc = F32X16_ZERO;
        const LAS bf16* ka = Kl + ((kh * 3 + kt) * 32 + r) * LDP + hq * 8;
#pragma unroll
        for (int ks = 0; ks < 4; ++ks) acc = __builtin_amdgcn_mfma_f32_32x32x16_bf16(*(const LAS bf16x8*)(ka + ks * 16), qf[ks], acc, 0, 0, 0);
#pragma unroll
        for (int i = 0; i < 16; ++i) {
            const int j = (kh * 3 + kt) * 32 + acc_row(i, hq), df = tq + 127 - j, kp = t0 - 127 + j;
            const bool valid = (df >= 0) && (df < 128) && (kp >= 0);
            const float s = valid ? acc[i] * 0.125f + Bl[qh * 128 + (df & 127)] : -INFINITY;
            acc[i] = s; mx = fmaxf(mx, s);
        }
        sc[kt] = acc;
    }
    mx = fmaxf(mx, __shfl_xor(mx, 32));
    if (hq == 0) Ms[(rt * 2 + kh) * 32 + r] = mx;
    __syncthreads();
    mx = fmaxf(fmaxf(mx, Ms[(rt * 2 + (kh ^ 1)) * 32 + r]), sink);
    float sum = 0.f;
#pragma unroll
    for (int kt = 0; kt < 3; ++kt)
#pragma unroll
        for (int g4 = 0; g4 < 4; ++g4) {
            const float p0 = __expf(sc[kt][4 * g4] - mx), p1 = __expf(sc[kt][4 * g4 + 1] - mx), p2 = __expf(sc[kt][4 * g4 + 2] - mx), p3 = __expf(sc[kt][4 * g4 + 3] - mx);
            sum += (p0 + p1) + (p2 + p3);
            v2u pk; pk.x = pk2(p0, p1); pk.y = pk2(p2, p3);
            *(LAS v2u*)(Pl + (rt * 32 + r) * SW_VP + (kh * 3 + kt) * 32 + 8 * g4 + 4 * hq) = pk;
        }
    sum += __shfl_xor(sum, 32);
    if (hq == 0) Ss[(rt * 2 + kh) * 32 + r] = sum;
    __syncthreads();
    {
        f32x16 o = F32X16_ZERO;
        const LAS bf16* pa = Pl + (rt * 32 + r) * SW_VP + hq * 8; const LAS bf16* vb = VT + (kh * 32 + r) * SW_VP; const int vsw = ((kh * 32 + r) >> 3) & 7;
#pragma unroll
        for (int ks = 0; ks < 12; ++ks) o = __builtin_amdgcn_mfma_f32_32x32x16_bf16(*(const LAS bf16x8*)(pa + ks * 16), *(const LAS bf16x8*)(vb + (((ks * 2 + hq) ^ vsw) << 3)), o, 0, 0, 0);
        bf16* mix = (bf16*)(F.ws + WS_MIX);
#pragma unroll
        for (int i = 0; i < 16; ++i) {
            const int q = acc_row(i, hq);
            const float m0 = Ms[(rt * 2 + 0) * 32 + q], m1 = Ms[(rt * 2 + 1) * 32 + q], mm = fmaxf(fmaxf(m0, m1), sink);
            const float den = (Ss[(rt * 2 + 0) * 32 + q] + Ss[(rt * 2 + 1) * 32 + q]) + __expf(sink - mm);
            mix[(size_t)(seqrow0 + t0 + qhalf * 32 + q) * D + 256 + head * 64 + kh * 32 + r] = f2bf_s(o[i] * rcpf_(den));
        }
    }
    if (t0 == SEQ - 64) {
        for (int e = tid; e < 128 * 16; e += 512) { const int wv = e >> 4, sg = e & 15;
            const bf16* p = proj + (size_t)(seqrow0 + SEQ - 128 + wv) * NPROJ + kvh * 64 + sg * 4;
            const size_t o = ((((size_t)l * NB + b) * 128 + wv) * 2 + kvh) * 64 + sg * 4;
            const v2u ku = *(const v2u*)(p + 1024), vu = *(const v2u*)(p + 1152);
            *(f32x4*)(F.out + O_PK + o) = (f32x4){bflo(ku.x), bfhi(ku.x), bflo(ku.y), bfhi(ku.y)};
            *(f32x4*)(F.out + O_PV + o) = (f32x4){bflo(vu.x), bfhi(vu.x), bflo(vu.y), bfhi(vu.y)}; }
    }
    __syncthreads();
}

__device__ __forceinline__ void scan_phase(Frame& F, int l) {
    const int e = F.vcu * 512 + F.tid;
    if (F.G * 512 >= 131072) {
        const int pe = e & 65535, bh = pe >> 11, el = (pe & 2047) * 2;
        if (e < 65536) {
            unsigned* sl = (unsigned*)((bf16*)(F.ws + WS_SSDLOC) + (size_t)bh * NCH * 4096 + el); const float* dc = (const float*)(F.ws + WS_SMALL) + bh * NCH;
            unsigned v[NCH];
#pragma unroll
            for (int c = 0; c < NCH; ++c) v[c] = sl[(size_t)c * 2048];
            float r0 = 0.f, r1 = 0.f;
#pragma unroll
            for (int c = 0; c < NCH; ++c) { sl[(size_t)c * 2048] = pk2(r0, r1); const float d = dc[c]; r0 = r0 * d + bflo(v[c]); r1 = r1 * d + bfhi(v[c]); }
            float* o = F.out + O_PSSM + ((size_t)l * 32 + bh) * 4096 + el; o[0] = r0; o[1] = r1;
        } else {
            unsigned* sl = (unsigned*)((bf16*)(F.ws + WS_HGLOC) + (size_t)bh * NCH * 4096 + el); const float* dc = (const float*)(F.ws + WS_SMALL) + 1024 + (size_t)bh * NCH * 64 + (el & 63);
            unsigned v[NCH];
#pragma unroll
            for (int c = 0; c < NCH; ++c) v[c] = sl[(size_t)c * 2048];
            float r0 = 0.f, r1 = 0.f;
#pragma unroll
            for (int c = 0; c < NCH; ++c) { sl[(size_t)c * 2048] = pk2(r0, r1); r0 = r0 * dc[c * 64] + bflo(v[c]); r1 = r1 * dc[c * 64 + 1] + bfhi(v[c]); }
            float* o = F.out + O_PHG + ((size_t)l * 32 + bh) * 4096 + (el & 63) * 64 + (el >> 6); o[0] = r0; o[64] = r1;
        }
        if (e < NB * 256) {
            const int b = e >> 8, ch = e & 255;
            float* hl = (float*)(F.ws + WS_SMALL) + 1024 + 65536 + (size_t)b * NCH * 256 + ch; const float* al = hl + 65536;
            float run = 0.f, vv[NCH], aa[NCH];
#pragma unroll
            for (int c = 0; c < NCH; ++c) { vv[c] = hl[c * 256]; aa[c] = al[c * 256]; }
#pragma unroll
            for (int c = 0; c < NCH; ++c) { hl[c * 256] = run; run = run * aa[c] + vv[c]; }
            F.out[O_PLRU + ((size_t)l * NB + b) * 256 + ch] = run;
        }
    }
}
constexpr int M1_SSD = 0, M1_SSSD = 256, M1_SHG = 320, M1_SLRU = 384, M1_SSWA = 448, M1_END = 704;
constexpr int M2_SSD = 0, M2_SWA = 256, M2_END = 768;
__device__ __forceinline__ int queue_next(Frame& F, int q) {
    const unsigned shard = blockIdx.x & 7u;
    __syncthreads();
    if (F.tid == 0) F.MISC[16] = __hip_atomic_fetch_add((unsigned*)(F.ctl + CW_QUEUE + 64 * (q * 8 + shard)), 1u, __ATOMIC_RELAXED, __HIP_MEMORY_SCOPE_AGENT) * 8u + shard;
    __syncthreads();
    return (int)F.MISC[16];
}
__device__ __forceinline__ void mixer_phase1(Frame& F0, int l, int qofs = 0) {
    for (;;) {
        int it = queue_next(F0, 2 * l + qofs);
#if defined(PROBE_M1Q)
        if (it >= M1_END + 2048) break;
        if (it >= M1_END) continue;
#elif defined(PROBE_M1S)
        if (it >= M1_END + 448) break;
        if (it >= M1_END) it -= 448;
#elif defined(PROBE_M1P)
        if (it >= M1_END + 256) break;
        if (it >= M1_END) it -= M1_END;
#else
        if (it >= M1_END) break;
#endif
#ifdef PROBE_M1T
        if (qofs && !(it >= PROBE_LO && it < PROBE_HI)) continue;
#endif
        Frame F = F0; OPAQUE_TID(F);
        if (it < M1_SSSD) {
            unsigned short frw[32], vrw[32]; v4u rawr[5];
            hgrn_p1_load(F, it, frw, vrw);
            ssd_mfma_p1(F, l, it);
            lru_raw_load(F, it, rawr);
            hgrn_mfma_p1(F, l, it, frw, vrw);
            lru_mfma<false, true>(F, l, it, &rawr);
        }
        else if (it < M1_SHG) ssd_item(F, l, 2, it - M1_SSSD);
        else if (it < M1_SLRU) hgrn_item(F, l, 2, (it - M1_SHG) * 8 + F.wave);
        else if (it < M1_SSWA) lru_item(F, l, 2, (it - M1_SLRU) * 8 + F.wave);
        else swa_item<true>(F, l, it - M1_SSWA);
    }
}
constexpr int CW_GRP = 32768;
__device__ __forceinline__ void group_barrier(Frame& F) {
    asm volatile("s_waitcnt vmcnt(0)" ::: "memory");
    __syncthreads();
    if (threadIdx.x == 0) {
        unsigned* cnt = (unsigned*)(F.ctl + CW_GRP + 64 * (blockIdx.x & 7u)); unsigned* tmo = (unsigned*)(F.ctl + CW_BAR) + XB_TMO;
        const unsigned n = (gridDim.x - (blockIdx.x & 7u) + 7u) / 8u, gen = F.MISC[10], target = (gen + 1u) * n;
#ifndef PROBE_NOREL
        __builtin_amdgcn_fence(__ATOMIC_RELEASE, "agent");
        asm volatile("s_waitcnt vmcnt(0)" ::: "memory");
#endif
        (void)xb_add(cnt, 1u);
        XB_SPIN((int)(xb_ld(cnt) - target) < 0, tmo - XB_TMO);
#ifndef PROBE_NOACQ
        __builtin_amdgcn_fence(__ATOMIC_ACQUIRE, "agent");
        asm volatile("s_waitcnt vmcnt(0)" ::: "memory");
#endif
        F.MISC[10] = gen + 1u;
    }
    __syncthreads();
}
constexpr int CW_CHAIN = 24576;
__device__ __forceinline__ void chain_publish(Frame& F, gu32* cnt) {
    asm volatile("s_waitcnt vmcnt(0)" ::: "memory");
    __syncthreads();
    if (F.tid == 0) {
        __builtin_amdgcn_fence(__ATOMIC_RELEASE, "agent");
        asm volatile("s_waitcnt vmcnt(0)" ::: "memory");
        __hip_atomic_fetch_add((unsigned*)cnt, 1u, __ATOMIC_RELAXED, __HIP_MEMORY_SCOPE_AGENT);
    }
}
__device__ __forceinline__ void chain_wait(Frame& F, gu32* cnt, unsigned target) {
    if (F.tid == 0) {
        unsigned sp = 0;
        while (__hip_atomic_load((unsigned*)cnt, __ATOMIC_RELAXED, __HIP_MEMORY_SCOPE_AGENT) < target) { __builtin_amdgcn_s_sleep(2); if (++sp > (1u << 22)) break; }
        __builtin_amdgcn_fence(__ATOMIC_ACQUIRE, "agent");
        asm volatile("s_waitcnt vmcnt(0)" ::: "memory");
    }
    __syncthreads();
}
constexpr int C_G2S = 16, C_G3S = 64, C_POS3 = C_G2S + 256, M2_QEND = M2_END + C_G2S + C_G3S;
template <int l> __device__ __forceinline__ void mixer_phase2(Frame& F0, int qofs = 0) {
    for (;;) {
        int it = queue_next(F0, 2 * l + 1 + qofs);
        if (it >= M2_QEND) break;
        Frame F = F0; OPAQUE_TID(F);
        if (qofs && (it < C_G2S || (it >= C_POS3 && it < C_POS3 + C_G3S))) continue;
        if (it < C_G2S) {
            pg8::Gemm g{(const bf16*)(F.ws + WS_MIX), (const bf16*)(F.ws + WS_WOUT) + (size_t)l * D * D, M, D, D, 0, 0}; pg8::OneUnit S{MP / 256 + (it >> 2), it & 3, 0};
            pg8::EpiResidualB E{(bf16*)(F.ws + WS_XB), (float*)(F.ws + WS_SSQB)};
            pg8::gemm_phase<pg8::EpiResidualB, pg8::OneUnit, true, true>(F.lds, g, S, E);
            chain_publish(F, F.ctl + CW_CHAIN + 64 * (l * 4 + (it >> 2)));
            continue;
        }
        if (it >= C_POS3 && it < C_POS3 + C_G3S) {
            const int j = it - C_POS3, pnl = j >> 4;
            chain_wait(F, F.ctl + CW_CHAIN + 64 * (l * 4 + pnl), 4u);
            pg8::Gemm g{(const bf16*)(F.ws + WS_XB), (const bf16*)(F.ws + WS_WUP) + (size_t)l * FF * D, M, FF, D, 0, 0}; pg8::OneUnit S{MP / 256 + pnl, j & 15, 0};
            pg8::EpiScaleBf16<1> E{(bf16*)(F.ws + WS_UP), FF, (const float*)(F.ws + WS_SSQB), (unsigned)((size_t)M * FF * 2)};
            pg8::gemm_phase<pg8::EpiScaleBf16<1>, pg8::OneUnit, true, true>(F.lds, g, S, E);
            continue;
        }
        it -= (it < C_POS3) ? C_G2S : C_G2S + C_G3S;
        if (it < M2_SWA) {
            HgPre hp0;
            ssd_mfma_p2<true>(F, l, it, &hp0);
            hgrn_mfma_p2<true>(F, l, it, &hp0);
            lru_p2_cached(F, l, it);
        }
        else { const int j = it - M2_SWA; swa_mfma(F, l, (j & 7) * 64 + (j >> 3)); }
    }
}

struct Args { const float* in[33]; float* out; unsigned char* ws; int ph_lo, ph_hi, li, pad; };
constexpr int N_PHASES = 1 + 2 * 8;
template <int KIND, int l> __device__ __forceinline__ void layer_phases(Frame& F, const XcdBarrier& bar, int lo, int hi) {
#define KON(k) (KIND == 0 || KIND == (k))
#define IN(k) (lo <= (k) && (k) < hi)
#define SEAM(k) do { if (IN(k) && IN((k) + 1)) xcd_barrier(bar); } while (0)
#define PHASE_FRAME() Frame Fm = F; OPAQUE_TID(Fm);
#define WSP(T, off) ((T*)(F.ws + (off)))
        const int pb = 1 + 8 * l;
        if constexpr (KON(2)) if (IN(pb)) {
            pg8::Gemm g{WSP(bf16, WS_XB), WSP(bf16, WS_WIN) + (size_t)l * NPROJ * D, M, NPROJ, D}; pg8::StaticOrder S; S.init(M, NPROJ, F.G, (int)blockIdx.x);
            pg8::EpiScaleBf16<0> E{WSP(bf16, WS_PROJ), NPROJ, WSP(float, WS_SSQA), (unsigned)((size_t)M * NPROJ * 2)};
            pg8::gemm_phase<pg8::EpiScaleBf16<0>, pg8::StaticOrder, true, true>(F.lds, g, S, E);
#ifdef DBL_G1
            xcd_barrier(bar); pg8::gemm_phase<pg8::EpiScaleBf16<0>, pg8::StaticOrder, true, true>(F.lds, g, S, E);
#endif
        }
        SEAM(pb);
#ifndef SKIP_M1
        if constexpr (KON(3)) if (IN(pb + 1)) { PHASE_FRAME(); mixer_phase1(Fm, l);
#ifdef DBL_M1
            xcd_barrier(bar); mixer_phase1(Fm, l, 8);
#endif
        }
#endif
        SEAM(pb + 1);
#ifndef SKIP_M2
        if constexpr (KON(9)) if (IN(pb + 2)) { PHASE_FRAME(); scan_phase(Fm, l); }
        SEAM(pb + 2);
        if constexpr (KON(4)) if (IN(pb + 3)) { PHASE_FRAME(); mixer_phase2<l>(Fm);
#ifdef DBL_M2
            xcd_barrier(bar); mixer_phase2<l>(Fm, 8);
#endif
        }
#endif
        SEAM(pb + 3);
        if constexpr (KON(5)) if (IN(pb + 4)) {
            pg8::Gemm g{WSP(bf16, WS_MIX), WSP(bf16, WS_WOUT) + (size_t)l * D * D, MP, D, D}; pg8::StaticOrder S; S.init(MP, D, F.G, (int)blockIdx.x);
            pg8::EpiResidualB E{WSP(bf16, WS_XB), WSP(float, WS_SSQB)};
            pg8::gemm_phase<pg8::EpiResidualB, pg8::StaticOrder, true, true>(F.lds, g, S, E);
        }
        SEAM(pb + 4);
        if constexpr (KON(6)) if (IN(pb + 5)) {
            pg8::Gemm g{WSP(bf16, WS_XB), WSP(bf16, WS_WUP) + (size_t)l * FF * D, MP, FF, D}; pg8::StaticOrder S; S.init(MP, FF, F.G, (int)blockIdx.x);
            pg8::EpiScaleBf16<1> E{WSP(bf16, WS_UP), FF, WSP(float, WS_SSQB), (unsigned)((size_t)M * FF * 2)};
            pg8::gemm_phase<pg8::EpiScaleBf16<1>, pg8::StaticOrder, true, true>(F.lds, g, S, E);
#ifdef DBL_G3
            xcd_barrier(bar); pg8::gemm_phase<pg8::EpiScaleBf16<1>, pg8::StaticOrder, true, true>(F.lds, g, S, E);
#endif
#ifdef PROBE_BAR
#pragma unroll 1
            for (int pbi = 0; pbi < 16; ++pbi) xcd_barrier(bar);
#endif
        }
        SEAM(pb + 5);
        if constexpr (KON(7)) if (IN(pb + 6)) {
            { pg8::Gemm g{WSP(bf16, WS_UP), WSP(bf16, WS_WDN) + (size_t)l * D * FF, M, D, FF / G4_KP, FF, (FF / G4_KP) * 2}; pg8::SplitOrder S{F.G, (int)blockIdx.x, MP / 256, G4_KP};
              pg8::EpiPartial E{WSP(bf16, WS_MIX), MP / 256, G4_KP};
              pg8::gemm_phase<pg8::EpiPartial, pg8::SplitOrder, true, true>(F.lds, g, S, E); }
            { pg8::Gemm g{WSP(bf16, WS_UP), WSP(bf16, WS_WDN) + (size_t)l * D * FF, MP, D, FF, 0, 0}; pg8::StaticOrder S; S.init(MP, D, F.G, (int)blockIdx.x);
              pg8::EpiResidualB E{WSP(bf16, WS_XB), WSP(float, WS_SSQA)};
              pg8::gemm_phase<pg8::EpiResidualB, pg8::StaticOrder, true, true>(F.lds, g, S, E); }
        }
        SEAM(pb + 6);
        if constexpr (KON(10)) if (IN(pb + 7)) { PHASE_FRAME(); sample_reduce<l == 1>(Fm); if (l == 1) final_norm(Fm); else dt_pass(Fm, 1, MP); }
        SEAM(pb + 7);
#undef KON
#undef IN
#undef SEAM
#undef PHASE_FRAME
#undef WSP
}
template <int KIND> __global__ void __launch_bounds__(NWAVES * 64, 2) mk_fwd(Args args) {
#define KON(k) (KIND == 0 || KIND == (k))
    extern __shared__ __attribute__((aligned(16))) unsigned char lds[];
    Frame F;
    F.lds = (LAS unsigned char*)lds;
    F.MISC = (volatile LAS unsigned*)(F.lds + MISC_OFF);
    F.tid = threadIdx.x; F.lane = F.tid & 63; F.wave = __builtin_amdgcn_readfirstlane(F.tid >> 6);
    F.G = gridDim.x; { const int bx = blockIdx.x; F.vcu = (F.G % 8 == 0) ? (bx % 8) * (F.G / 8) + bx / 8 : bx; }
    F.out = args.out; F.ws = args.ws; F.ctl = (gu32*)(args.ws + WS_CTL);
    for (int u = F.tid; u < (LDS_BYTES - LDSCTL_OFF) / 4; u += NWAVES * 64) ((LAS unsigned*)(F.lds + LDSCTL_OFF))[u] = 0u;
    __syncthreads();
    if (F.tid == 0) {
#pragma unroll
        for (int i = 0; i < 33; ++i) *(LAS unsigned long long*)(F.lds + PTAB_OFF + 8 * i) = (unsigned long long)args.in[i];
    }
    __syncthreads();
    XcdBarrier bar; bar.bar = (unsigned*)(F.ctl + CW_BAR); bar.x = 0; bar.st = nullptr;
    bar = xcd_barrier_post((unsigned*)(F.ctl + CW_BAR), F.MISC + 8);
    const int lo = args.ph_lo, hi = args.ph_hi;
#define IN(k) (lo <= (k) && (k) < hi)
#define SEAM(k) do { if (IN(k) && IN((k) + 1)) xcd_barrier(bar); } while (0)
#define PHASE_FRAME() Frame Fm = F; OPAQUE_TID(Fm);
#define WSP(T, off) ((T*)(F.ws + (off)))
    if constexpr (KON(1)) if (IN(0)) { PHASE_FRAME(); p0_prologue(Fm);
#ifdef DBL_P0
        xcd_barrier(bar); p0_prologue(Fm);
#endif
    }
    SEAM(0);

    layer_phases<KIND, 0>(F, bar, lo, hi);
    layer_phases<KIND, 1>(F, bar, lo, hi);
#undef IN
#undef SEAM
}

template <int KIND> static void launch_kind(const Args& a, int grid, hipStream_t stream) {
    static bool attr_set = false;
    if (!attr_set) { (void)hipFuncSetAttribute((const void*)mk_fwd<KIND>, hipFuncAttributeMaxDynamicSharedMemorySize, LDS_BYTES); attr_set = true; }
    hipLaunchKernelGGL(mk_fwd<KIND>, dim3(grid), dim3(NWAVES * 64), LDS_BYTES, stream, a);
}
extern "C" void kernel_launch(void* const* d_in, const int* in_sizes, int n_in, void* d_out, int out_size, void* d_ws, size_t ws_size, hipStream_t stream) {
    static int grid = 0;
    if (grid == 0) {
        if (n_in != 33 || out_size != (int)O_END || ws_size < WS_END) { fprintf(stderr, "kernel_launch: unexpected shapes n_in %d out %d ws %zu\n", n_in, out_size, ws_size); grid = -1; return; }
        int dev = 0, cus = 0;
        if (hipGetDevice(&dev) != hipSuccess || hipDeviceGetAttribute(&cus, hipDeviceAttributeMultiprocessorCount, dev) != hipSuccess) { grid = -1; return; }
        grid = cus;
    }
    if (grid < 0) return;
    (void)hipMemsetAsync((char*)d_ws + WS_CTL, 0, CTL_ZERO_BYTES, stream);
    Args a{};
    for (int i = 0; i < 33; ++i) a.in[i] = (const float*)d_in[i];
    a.out = (float*)d_out; a.ws = (unsigned char*)d_ws;
    a.ph_lo = 0; a.ph_hi = N_PHASES; a.li = 0;
    launch_kind<0>(a, grid, stream);
}
```

```cpp
#include <hip/hip_runtime.h>
#include <cstdio>
#include <cstdint>
#include <cmath>
namespace pg8 {
#define PG8_LAS __attribute__((address_space(3)))
typedef unsigned short bf16_t;
typedef short bf16x8 __attribute__((ext_vector_type(8)));
typedef float f32x4 __attribute__((ext_vector_type(4)));
typedef unsigned u32x4 __attribute__((ext_vector_type(4)));
constexpr int BM = 256, BK = 64, HALF = 128, HTB = HALF * BK * 2  , STAGE_BYTES = 8 * HTB, NXCD = 8, WGM = 8;

__host__ __device__ __forceinline__ int lds_byte(int r, int c) { const int st = (r >> 4) * 2 + (c >> 5), rr = r & 15, cc = c & 31, ob = rr * 64 + cc * 2; return st * 1024 + (ob ^ (((ob >> 9) & 1) << 5)); }
__host__ __device__ __forceinline__ void stage_rc(int b, int& R, int& C) { const int st = b / 1024, sb = b % 1024, swz = sb ^ (((sb >> 9) & 1) << 5); R = (st >> 1) * 16 + swz / 64; C = (st & 1) * 32 + (swz % 64) / 2; }
__host__ __device__ __forceinline__ int perm32(int rho) { const int n = rho >> 4, i = rho & 15; return 8 * (i >> 2) + 4 * n + (i & 3); }

struct Unit { int pm, pn, kp; };
struct Gemm { const bf16_t* A; const bf16_t* Bt; int M, N, K; int ld; int kpb; };

struct StaticOrder {
    int nM, nN, nwg, G, c;
    __host__ __device__ void init(int M, int N, int G_, int c_) { nM = M / BM; nN = N / BM; nwg = nM * nN; G = G_; c = c_; }
    __host__ __device__ bool next(int i, Unit& u) const {
        const long L = (long)i * G + c; if (L >= nwg) return false;
        int wgid = (int)L; { const int q = nwg / NXCD, r = nwg % NXCD, xcd = wgid % NXCD, off = wgid / NXCD; wgid = (xcd < r ? xcd * (q + 1) : r * (q + 1) + (xcd - r) * q) + off; }
        const int nig = WGM * nN, gid = wgid / nig, fm = gid * WGM, gsz = (nM - fm) < WGM ? (nM - fm) : WGM;
        u.pm = fm + ((wgid % nig) % gsz); u.pn = (wgid % nig) / gsz; u.kp = 0; return true;
    }
    __device__ __forceinline__ void a_ready(const Unit&) const {}
    __device__ __forceinline__ void done(const Unit&) const {}
};
__device__ __forceinline__ unsigned cvt_pk_bf16(float lo, float hi) { unsigned r; asm volatile("v_cvt_pk_bf16_f32 %0, %1, %2" : "=v"(r) : "v"(lo), "v"(hi)); return r; }
typedef float f32x2 __attribute__((ext_vector_type(2)));
__device__ __forceinline__ float xsum4(const f32x4 v) { return (v[0] + v[1]) + (v[2] + v[3]); }
template <int ACT> struct EpiScaleBf16 {
    static constexpr bool PERM = true, AFTER_DRAIN = false;
    bf16_t* O; int ldc; const float* ssq; unsigned obytes;
    __device__ __forceinline__ void operator()(const f32x4 (&acc)[2][2][4][2], const Unit& u, int wr, int wc, int fr, int fq) const {
        const __amdgpu_buffer_rsrc_t orsrc = __builtin_amdgcn_make_buffer_rsrc((void*)O, 0, (int)obytes, 0x00020000);
        const int row0 = u.pm * BM + wr * 64 + fr, col0 = u.pn * BM + wc * 32 + 8 * fq;
        f32x4 pvs[2][4];
#pragma unroll
        for (int ai = 0; ai < 2; ++ai)
#pragma unroll
            for (int m = 0; m < 4; ++m) pvs[ai][m] = *(const f32x4*)(ssq + (size_t)(row0 + ai * HALF + m * 16) * 16 + 4 * fq);
#pragma unroll
        for (int ai = 0; ai < 2; ++ai)
#pragma unroll
            for (int m = 0; m < 4; ++m) {
                const int row = row0 + ai * HALF + m * 16;
                const f32x4 pv = pvs[ai][m];
                float s = xsum4(pv); s += __shfl_xor(s, 16); s += __shfl_xor(s, 32);
                const float rs = 1.0f / sqrtf(s * (1.0f / 1024.0f) + 1e-6f);
                bf16_t* rowp = O + (size_t)row * ldc + col0;
#pragma unroll
                for (int bj = 0; bj < 2; ++bj) {
                    f32x4 v0 = acc[ai][bj][m][0] * rs, v1 = acc[ai][bj][m][1] * rs;
                    if (ACT == 1) {
#pragma unroll
                        for (int e = 0; e < 4; ++e) { const float a = fmaxf(v0[e], 0.f), b = fmaxf(v1[e], 0.f); v0[e] = a * a; v1[e] = b * b; }
                    }
                    u32x4 w; w.x = cvt_pk_bf16(v0[0], v0[1]); w.y = cvt_pk_bf16(v0[2], v0[3]); w.z = cvt_pk_bf16(v1[0], v1[1]); w.w = cvt_pk_bf16(v1[2], v1[3]);
                    __builtin_amdgcn_raw_buffer_store_b128(w, orsrc, (unsigned)(((size_t)row * ldc + col0 + bj * HALF) * 2), 0, 16);
                }
            }
    }
};
struct EpiResidual {
    static constexpr bool PERM = false, AFTER_DRAIN = false;
    const float* xin_p; const float* xin_s; int split_row;
    float* Xout; bf16_t* xb; float* ssq;
    __device__ __forceinline__ void operator()(const f32x4 (&acc)[2][2][4][2], const Unit& u, int wr, int wc, int fr, int fq) const {
        typedef unsigned u32x2v __attribute__((ext_vector_type(2)));
        const int col0 = u.pn * BM + wc * 32 + 4 * fq;
#pragma unroll
        for (int ai = 0; ai < 2; ++ai)
#pragma unroll
            for (int m = 0; m < 4; ++m) {
                const int row = u.pm * BM + ai * HALF + wr * 64 + m * 16 + fr;
                const float* src = (row < split_row) ? xin_p + (size_t)row * 1024 : xin_s + (size_t)(row - split_row) * 1024;
                float q = 0.f;
#pragma unroll
                for (int bj = 0; bj < 2; ++bj)
#pragma unroll
                    for (int n = 0; n < 2; ++n) {
                        const int off = col0 + bj * HALF + n * 16;
                        const f32x4 o = *(const f32x4*)(src + off) + acc[ai][bj][m][n];
                        *(f32x4*)(Xout + (size_t)row * 1024 + off) = o;
                        u32x2v w; w.x = cvt_pk_bf16(o[0], o[1]); w.y = cvt_pk_bf16(o[2], o[3]);
                        *(u32x2v*)(xb + (size_t)row * 1024 + off) = w;
                        q += (o[0] * o[0] + o[1] * o[1]) + (o[2] * o[2] + o[3] * o[3]);
                    }
                q += __shfl_xor(q, 16); q += __shfl_xor(q, 32);
                if (fq == 0) ssq[(size_t)row * 16 + u.pn * 4 + wc] = q;
            }
    }
};
struct EpiPartial {
    static constexpr bool PERM = true, AFTER_DRAIN = false;
    bf16_t* slab; int pm0, kparts;
    __device__ __forceinline__ void operator()(const f32x4 (&acc)[2][2][4][2], const Unit& u, int wr, int wc, int fr, int fq) const {
        bf16_t* base = slab + (size_t)(((u.pm - pm0) * 4 + u.pn) * kparts + u.kp) * 65536;
        const int col0 = wc * 32 + 8 * fq;
#pragma unroll
        for (int ai = 0; ai < 2; ++ai)
#pragma unroll
            for (int m = 0; m < 4; ++m) {
                const int row = ai * HALF + wr * 64 + m * 16 + fr;
#pragma unroll
                for (int bj = 0; bj < 2; ++bj) { const f32x4 v0 = acc[ai][bj][m][0], v1 = acc[ai][bj][m][1];
                    u32x4 w; w.x = cvt_pk_bf16(v0[0], v0[1]); w.y = cvt_pk_bf16(v0[2], v0[3]); w.z = cvt_pk_bf16(v1[0], v1[1]); w.w = cvt_pk_bf16(v1[2], v1[3]);
                    *(u32x4*)(base + row * 256 + col0 + bj * HALF) = w; }
            }
    }
};
struct SplitOrder {
    int G, c, pm0, kparts;
    __device__ bool next(int i, Unit& u) const { const int L = i * G + c; if (L >= 16 * kparts) return false; const int tile = L / kparts; u.kp = L % kparts; u.pm = pm0 + tile / 4; u.pn = tile % 4; return true; }
    __device__ __forceinline__ void a_ready(const Unit&) const {}
    __device__ __forceinline__ void done(const Unit&) const {}
};
struct OneUnit {
    int pm, pn, kp;
    __device__ bool next(int i, Unit& u) const { if (i) return false; u.pm = pm; u.pn = pn; u.kp = kp; return true; }
    __device__ __forceinline__ void a_ready(const Unit&) const {}
    __device__ __forceinline__ void done(const Unit&) const {}
};
struct EpiResidualB {
    static constexpr bool PERM = true, AFTER_DRAIN = false;
    bf16_t* xb; float* ssq;
    __device__ __forceinline__ void operator()(const f32x4 (&acc)[2][2][4][2], const Unit& u, int wr, int wc, int fr, int fq) const {
        const int row0 = u.pm * BM + wr * 64 + fr, col0 = u.pn * BM + wc * 32 + 8 * fq;
        u32x4 rv[2][4][2];
#pragma unroll
        for (int ai = 0; ai < 2; ++ai)
#pragma unroll
            for (int m = 0; m < 4; ++m)
#pragma unroll
                for (int bj = 0; bj < 2; ++bj) rv[ai][m][bj] = *(const u32x4*)(xb + (size_t)(row0 + ai * HALF + m * 16) * 1024 + col0 + bj * HALF);
#pragma unroll
        for (int ai = 0; ai < 2; ++ai)
#pragma unroll
            for (int m = 0; m < 4; ++m) {
                const int row = row0 + ai * HALF + m * 16;
                bf16_t* rowp = xb + (size_t)row * 1024 + col0;
                float q = 0.f;
#pragma unroll
                for (int bj = 0; bj < 2; ++bj) {
                    const u32x4 r = rv[ai][m][bj];
                    const f32x4 v0 = acc[ai][bj][m][0] + (f32x4){__builtin_bit_cast(float, r.x << 16), __builtin_bit_cast(float, r.x & 0xffff0000u), __builtin_bit_cast(float, r.y << 16), __builtin_bit_cast(float, r.y & 0xffff0000u)};
                    const f32x4 v1 = acc[ai][bj][m][1] + (f32x4){__builtin_bit_cast(float, r.z << 16), __builtin_bit_cast(float, r.z & 0xffff0000u), __builtin_bit_cast(float, r.w << 16), __builtin_bit_cast(float, r.w & 0xffff0000u)};
                    q += ((v0[0] * v0[0] + v0[1] * v0[1]) + (v0[2] * v0[2] + v0[3] * v0[3])) + ((v1[0] * v1[0] + v1[1] * v1[1]) + (v1[2] * v1[2] + v1[3] * v1[3]));
                    u32x4 w; w.x = cvt_pk_bf16(v0[0], v0[1]); w.y = cvt_pk_bf16(v0[2], v0[3]); w.z = cvt_pk_bf16(v1[0], v1[1]); w.w = cvt_pk_bf16(v1[2], v1[3]);
                    *(u32x4*)(rowp + bj * HALF) = w;
                }
                q += __shfl_xor(q, 16); q += __shfl_xor(q, 32);
                if (fq == 0) ssq[(size_t)row * 16 + u.pn * 4 + wc] = q;
            }
    }
};
template <class Epi, class Sched, bool ALIGN_EPI = false, bool SP2 = false>
__device__ __forceinline__ void gemm_phase(PG8_LAS unsigned char* lds, const Gemm g, const Sched& S, const Epi& E) {
    int tid_ = threadIdx.x; asm volatile("" : "+v"(tid_));
    const int tid = tid_, wid = __builtin_amdgcn_readfirstlane(tid >> 6), lane = tid & 63, wr = wid >> 2, wc = wid & 3, fr = lane & 15, fq = lane >> 4;
    const int K = g.K, nt = K / BK, LD = g.ld ? g.ld : g.K;
    unsigned voffA[2], voffB[2];
#pragma unroll
    for (int i = 0; i < 2; ++i) { int R, C; stage_rc(tid * 16 + i * 8192, R, C); const int Rb = Epi::PERM ? ((R & ~31) + perm32(R & 31)) : R;
        voffA[i] = (unsigned)(R * LD + C) * 2u; voffB[i] = (unsigned)(Rb * LD + C) * 2u; }
    const size_t kstep = (size_t)(BK * 2);
    const size_t hstep = (size_t)HALF * LD * 2;
    const size_t tstep = 2 * hstep;
    const unsigned ldsw = (unsigned)wid * 1024u;
    const int aoff = lds_byte(wr * 64 + fr, fq * 8), boff = lds_byte(wc * 32 + fr, fq * 8);
#define PG8_SA(b, h) (((b) * 2 + (h)) * HTB)
#define PG8_SB(b, h) ((4 + (b) * 2 + (h)) * HTB)
#define PG8_STAGE(bufoff, gbase, voff) do { _Pragma("unroll") for (int _i = 0; _i < 2; ++_i) \
        __builtin_amdgcn_global_load_lds((const unsigned*)((const char*)(gbase) + (voff)[_i]), (PG8_LAS unsigned*)(lds + (bufoff) + ldsw + _i * 8192), 16, 0, 0); } while (0)
#define PG8_LDA(dst, b, h) do { _Pragma("unroll") for (int m = 0; m < 4; ++m) _Pragma("unroll") for (int k = 0; k < 2; ++k) dst[m][k] = *(const PG8_LAS bf16x8*)(lds + PG8_SA(b, h) + aoff + m * 2048 + k * 1024); } while (0)
#define PG8_LDB(dst, b, h) do { _Pragma("unroll") for (int n = 0; n < 2; ++n) _Pragma("unroll") for (int k = 0; k < 2; ++k) dst[n][k] = *(const PG8_LAS bf16x8*)(lds + PG8_SB(b, h) + boff + n * 2048 + k * 1024); } while (0)
#define PG8_MMA(ai, bj, At, Bt) do { __builtin_amdgcn_s_setprio(1); _Pragma("unroll") for (int m = 0; m < 4; ++m) _Pragma("unroll") for (int n = 0; n < 2; ++n) _Pragma("unroll") for (int k = 0; k < 2; ++k) \
        acc[ai][bj][m][n] = __builtin_amdgcn_mfma_f32_16x16x32_bf16(Bt[n][k], At[m][k], acc[ai][bj][m][n], 0, 0, 0); __builtin_amdgcn_s_setprio(0); } while (0)
#define PG8_WAIT_V(n) asm volatile("s_waitcnt vmcnt(" #n ")" ::: "memory")
#define PG8_WAIT_L(n) asm volatile("s_waitcnt lgkmcnt(" #n ")" ::: "memory")
#define PG8_BAR __builtin_amdgcn_s_barrier()
#define PG8_SCHED __builtin_amdgcn_sched_barrier(0)
    Unit cur, nxt; int ui = 0;
    if (!S.next(0, cur)) return;
    f32x4 acc[2][2][4][2];
#pragma unroll
    for (int a = 0; a < 2; ++a)
#pragma unroll
        for (int b = 0; b < 2; ++b)
#pragma unroll
            for (int m = 0; m < 4; ++m)
#pragma unroll
                for (int n = 0; n < 2; ++n) acc[a][b][m][n] = (f32x4){0.f, 0.f, 0.f, 0.f};
    bf16x8 At[4][2], B0[2][2], B1[2][2];
    const char* cA = (const char*)g.A + (size_t)cur.pm * tstep + (size_t)cur.kp * g.kpb; const char* cB = (const char*)g.Bt + (size_t)cur.pn * tstep + (size_t)cur.kp * g.kpb;
    S.a_ready(cur);
    if constexpr (SP2) {
        PG8_STAGE(PG8_SB(0, 0), cB, voffB); PG8_STAGE(PG8_SB(0, 1), cB + hstep, voffB); PG8_STAGE(PG8_SA(0, 0), cA, voffA); PG8_STAGE(PG8_SA(0, 1), cA + hstep, voffA);
        if (wr == 1) PG8_BAR;
        PG8_WAIT_V(2); PG8_BAR;
        PG8_STAGE(PG8_SB(1, 0), cB + kstep, voffB); PG8_STAGE(PG8_SA(1, 0), cA + kstep, voffA); PG8_STAGE(PG8_SB(1, 1), cB + hstep + kstep, voffB);
        PG8_WAIT_V(6); PG8_BAR;
    } else {
        PG8_STAGE(PG8_SB(0, 0), cB, voffB); PG8_STAGE(PG8_SA(0, 0), cA, voffA); PG8_STAGE(PG8_SB(0, 1), cB + hstep, voffB); PG8_STAGE(PG8_SA(0, 1), cA + hstep, voffA);
        if (wr == 1) PG8_BAR;
        PG8_WAIT_V(4); PG8_BAR;
        PG8_STAGE(PG8_SB(1, 0), cB + kstep, voffB); PG8_STAGE(PG8_SA(1, 0), cA + kstep, voffA); PG8_STAGE(PG8_SB(1, 1), cB + hstep + kstep, voffB);
        PG8_WAIT_V(6); PG8_BAR;
    }
    for (;;) {
        const bool has_next = S.next(ui + 1, nxt);
        const char* nA = has_next ? (const char*)g.A + (size_t)nxt.pm * tstep + (size_t)nxt.kp * g.kpb : cA; const char* nB = has_next ? (const char*)g.Bt + (size_t)nxt.pn * tstep + (size_t)nxt.kp * g.kpb : cB;
        for (int t = 0; t < nt; t += 2) {
            const bool last = (t == nt - 2);
            const char* a1 = cA + (size_t)(t + 1) * kstep;
            const char* a2 = last ? nA : cA + (size_t)(t + 2) * kstep; const char* b2 = last ? nB : cB + (size_t)(t + 2) * kstep;
            const char* a3 = a2 + kstep; const char* b3 = b2 + kstep;
            if (last && has_next) S.a_ready(nxt);
            if constexpr (SP2) {
            PG8_LDB(B0, 0, 0); PG8_LDB(B1, 0, 1); PG8_SCHED; PG8_LDA(At, 0, 0); PG8_STAGE(PG8_SA(1, 1), a1 + hstep, voffA);
            PG8_WAIT_V(8); PG8_WAIT_L(0); PG8_BAR; PG8_MMA(0, 0, At, B0); PG8_MMA(0, 1, At, B1); PG8_BAR; PG8_SCHED;
            PG8_LDA(At, 0, 1); PG8_STAGE(PG8_SB(0, 0), b2, voffB); PG8_STAGE(PG8_SB(0, 1), b2 + hstep, voffB); PG8_STAGE(PG8_SA(0, 0), a2, voffA);
            PG8_WAIT_V(8); PG8_WAIT_L(0); PG8_BAR; PG8_MMA(1, 0, At, B0); PG8_MMA(1, 1, At, B1); PG8_BAR; PG8_SCHED;
            PG8_LDB(B0, 1, 0); PG8_LDB(B1, 1, 1); PG8_SCHED; PG8_LDA(At, 1, 0); PG8_STAGE(PG8_SA(0, 1), a2 + hstep, voffA);
            PG8_WAIT_V(8); PG8_WAIT_L(0); PG8_BAR; PG8_MMA(0, 0, At, B0); PG8_MMA(0, 1, At, B1); PG8_BAR; PG8_SCHED;
            PG8_LDA(At, 1, 1); PG8_STAGE(PG8_SB(1, 0), b3, voffB); PG8_STAGE(PG8_SB(1, 1), b3 + hstep, voffB); PG8_STAGE(PG8_SA(1, 0), a3, voffA);
            PG8_WAIT_V(8); PG8_WAIT_L(0); PG8_BAR; PG8_MMA(1, 0, At, B0); PG8_MMA(1, 1, At, B1); PG8_BAR; PG8_SCHED;
            } else {
            PG8_LDB(B0, 0, 0); PG8_SCHED; PG8_LDA(At, 0, 0); PG8_STAGE(PG8_SA(1, 1), a1 + hstep, voffA);
            PG8_WAIT_L(8); PG8_BAR; PG8_WAIT_L(0); PG8_MMA(0, 0, At, B0); PG8_BAR; PG8_SCHED;
            PG8_LDB(B1, 0, 1); PG8_STAGE(PG8_SB(0, 0), b2, voffB);
            PG8_BAR; PG8_WAIT_L(0); PG8_MMA(0, 1, At, B1); PG8_BAR;
            PG8_LDA(At, 0, 1); PG8_STAGE(PG8_SA(0, 0), a2, voffA);
            PG8_BAR; PG8_WAIT_L(0); PG8_MMA(1, 0, At, B0); PG8_BAR; PG8_SCHED;
            PG8_STAGE(PG8_SB(0, 1), b2 + hstep, voffB);
            PG8_WAIT_V(6); PG8_BAR; PG8_MMA(1, 1, At, B1); PG8_BAR;
            PG8_LDB(B0, 1, 0); PG8_SCHED; PG8_LDA(At, 1, 0); PG8_STAGE(PG8_SA(0, 1), a2 + hstep, voffA);
            PG8_WAIT_L(8); PG8_BAR; PG8_WAIT_L(0); PG8_MMA(0, 0, At, B0); PG8_BAR; PG8_SCHED;
            PG8_LDB(B1, 1, 1); PG8_STAGE(PG8_SB(1, 0), b3, voffB);
            PG8_BAR; PG8_WAIT_L(0); PG8_MMA(0, 1, At, B1); PG8_BAR;
            PG8_LDA(At, 1, 1); PG8_STAGE(PG8_SA(1, 0), a3, voffA);
            PG8_BAR; PG8_WAIT_L(0); PG8_MMA(1, 0, At, B0); PG8_BAR; PG8_SCHED;
            PG8_STAGE(PG8_SB(1, 1), b3 + hstep, voffB);
            PG8_WAIT_V(6); PG8_BAR; PG8_MMA(1, 1, At, B1); PG8_BAR;
            }
        }
        if constexpr (ALIGN_EPI) { if (wr == 0) PG8_BAR; }
        if constexpr (!Epi::AFTER_DRAIN) { E(acc, cur, wr, wc, fr, fq); S.done(cur); }
        if (!has_next) break;
#pragma unroll
        for (int a = 0; a < 2; ++a)
#pragma unroll
            for (int b = 0; b < 2; ++b)
#pragma unroll
                for (int m = 0; m < 4; ++m)
#pragma unroll
                    for (int n = 0; n < 2; ++n) acc[a][b][m][n] = (f32x4){0.f, 0.f, 0.f, 0.f};
        cur = nxt; cA = nA; cB = nB; ++ui;
        if constexpr (ALIGN_EPI) { if (wr == 1) PG8_BAR; }
    }
    PG8_WAIT_V(0);
    if constexpr (!ALIGN_EPI) { if (wr == 0) PG8_BAR; }
    PG8_BAR;
    if constexpr (Epi::AFTER_DRAIN) { E.fused(acc, cur, wr, wc, fr, fq, lds, wid, lane); S.done(cur); }
#undef PG8_SA
#undef PG8_SB
#undef PG8_STAGE
#undef PG8_LDA
#undef PG8_LDB
#undef PG8_MMA
#undef PG8_WAIT_V
#undef PG8_WAIT_L
#undef PG8_BAR
#undef PG8_SCHED
}
}
#define GAS __attribute__((address_space(1)))
#define LAS __attribute__((address_space(3)))
typedef unsigned short bf16;
typedef unsigned v4u __attribute__((ext_vector_type(4)));
typedef float f32x4 __attribute__((ext_vector_type(4)));
typedef short bf16x8 __attribute__((ext_vector_type(8)));
typedef GAS unsigned gu32;
typedef GAS unsigned long long gu64;
#define RLX_AGENT __ATOMIC_RELAXED, __HIP_MEMORY_SCOPE_AGENT
#define LDS_WAIT() asm volatile("s_waitcnt lgkmcnt(0)" ::: "memory")
#define VM_WAIT() asm volatile("s_waitcnt vmcnt(0)" ::: "memory")
__device__ __forceinline__ unsigned long long rt() { return __builtin_amdgcn_s_memrealtime(); }
__device__ __forceinline__ unsigned f2bf(float f) { unsigned u = __builtin_bit_cast(unsigned, f); return (u + 0x7fffu + ((u >> 16) & 1u)) >> 16; }
__device__ __forceinline__ unsigned pk2(float lo, float hi) { return f2bf(lo) | (f2bf(hi) << 16); }

#define XB_TMO      128
#define XB_XCNT(j)  (256  + 64 * (j))
#define XB_XSUB(j)  (1280 + 64 * (j))
#define XB_XGEN(j)  (2304 + 64 * (j))
#define XB_TOP      3328
#define XB_TOPGEN   3392
#define XCD_BAR_WORDS 3456
#define XB_SPIN_CAP (1u << 18)

__device__ __forceinline__ unsigned xb_ld(unsigned* p)              { return __hip_atomic_load(p, __ATOMIC_RELAXED, __HIP_MEMORY_SCOPE_AGENT); }
__device__ __forceinline__ unsigned xb_add(unsigned* p, unsigned v) { return __hip_atomic_fetch_add(p, v, __ATOMIC_RELAXED, __HIP_MEMORY_SCOPE_AGENT); }
__device__ __forceinline__ unsigned xb_xcc_id() { return (unsigned)__builtin_amdgcn_s_getreg((3 << 11) | 20) & 0xFu; }
#define XB_SPIN(cond, bar) do { unsigned _sp = 0; while (cond) { __builtin_amdgcn_s_sleep(1); \
    if ((++_sp & 255u) == 0u) { if (xb_ld(&(bar)[XB_TMO])) break; if (_sp > XB_SPIN_CAP) { atomicAdd(&(bar)[XB_TMO], 1u); break; } } } } while (0)

struct XcdBarrier {
    unsigned* bar; unsigned x;
    volatile LAS unsigned* st;
};

__device__ __forceinline__ XcdBarrier xcd_barrier_post(unsigned* bar, volatile LAS unsigned* st) {
    XcdBarrier b; b.bar = bar; b.x = xb_xcc_id(); b.st = st;
    if (threadIdx.x == 0) (void)xb_add(&bar[XB_XCNT(b.x)], 1u);
    return b;
}
__device__ __forceinline__ void xcd_barrier_complete(unsigned* bar, unsigned x, unsigned& nloc, unsigned& nx) {
    const unsigned G = gridDim.x * gridDim.y * gridDim.z;
    unsigned sum, cnt, mine, sp = 0u;
    for (;;) {
        sum = 0u; cnt = 0u; mine = 0u;
#pragma unroll
        for (unsigned j = 0; j < 16; ++j) { const unsigned c = xb_ld(&bar[XB_XCNT(j)]); sum += c; cnt += (c > 0u) ? 1u : 0u; mine = (j == x) ? c : mine; }
        if (sum == G) break;
        __builtin_amdgcn_s_sleep(1);
        if ((++sp & 255u) == 0u) { if (xb_ld(&bar[XB_TMO])) break; if (sp > XB_SPIN_CAP) { atomicAdd(&bar[XB_TMO], 1u); break; } }
    }
    nloc = mine > 0u ? mine : 1u; nx = cnt > 0u ? cnt : 1u;
}

__device__ __forceinline__ void xcd_barrier(const XcdBarrier& b) {
    asm volatile("s_waitcnt vmcnt(0)" ::: "memory");
    __syncthreads();
    if (threadIdx.x == 0) {
        unsigned* bar = b.bar;
        __builtin_amdgcn_s_waitcnt(0);
        unsigned nloc = b.st[0], nx = b.st[1];
        if (nloc == 0u) { xcd_barrier_complete(bar, b.x, nloc, nx); b.st[0] = nloc; b.st[1] = nx; }
        const unsigned old = xb_add(&bar[XB_XSUB(b.x)], 1u);
        const unsigned gen = old / nloc;
        if (old + 1u == (gen + 1u) * nloc) {
            __builtin_amdgcn_fence(__ATOMIC_RELEASE, "agent");
            asm volatile("s_waitcnt vmcnt(0)" ::: "memory");
            (void)xb_add(&bar[XB_TOP], 1u);
        }
        const unsigned target = (gen + 1u) * nx;
        asm volatile("buffer_inv sc1" ::: "memory");
        XB_SPIN((int)(xb_ld(&bar[XB_TOP]) - target) < 0, bar);
        asm volatile("s_waitcnt vmcnt(0)" ::: "memory");
    }
    __syncthreads();
}
constexpr int NWAVES = 8;
#ifndef MK_PER_PHASE
#define MK_PER_PHASE 0
#endif
constexpr int D = 1024, MP = 16384, MS = 1024, M = MP + MS, NPROJ = 2816, FF = 4096, NIN = 2820;
constexpr int SEQ = 2048, NB = 8, SB = 128, SL = 8, NCH = 32  ;
constexpr float EPS = 1e-6f;
constexpr size_t MiB = 1u << 20;
constexpr size_t WS_CTL = 0, CTL_ZERO_BYTES = 256 * 1024;
constexpr size_t WS_WDT = 512 * 1024;
constexpr size_t WS_LWT = 640 * 1024;
constexpr size_t WS_WIN = 1 * MiB;
constexpr size_t WS_WOUT = 12 * MiB;
constexpr size_t WS_WUP = 16 * MiB;
constexpr size_t WS_WDN = 32 * MiB;
constexpr size_t WS_XB = 48 * MiB;
constexpr size_t WS_UP = 82 * MiB;
constexpr size_t WS_PROJ = 82 * MiB;
constexpr size_t WS_SSDLOC = 176 * MiB;
constexpr size_t WS_HGLOC = 192 * MiB;
constexpr size_t WS_MIX = 218 * MiB;
constexpr size_t WS_SSQA = 252 * MiB;
constexpr size_t WS_SSQB = 253 * MiB + 512 * 1024;
constexpr size_t WS_SMALL = 255 * MiB;
constexpr size_t WS_DT = 254 * MiB + 640 * 1024;
constexpr size_t WS_END = 256 * MiB;
static_assert(WS_UP + (size_t)M * FF * 2 <= WS_MIX && WS_PROJ + (size_t)M * NPROJ * 2 <= WS_SSDLOC && WS_MIX + (size_t)M * D * 2 <= WS_SSQA && WS_SSQA + (size_t)M * 64 <= WS_SSQB && WS_SSQB + (size_t)M * 64 <= WS_DT && WS_DT + (size_t)M * 16 <= WS_SMALL, "ws map");
constexpr int CW_BAR = 4096;
constexpr int CW_QUEUE = 16384;
constexpr size_t O_Y = 0, O_PK = 17825792, O_PV = O_PK + 262144, O_PSSM = O_PV + 262144, O_PSSMC = O_PSSM + 262144, O_PHG = O_PSSMC + 24576,
                 O_PLRU = O_PHG + 262144, O_PLRUC = O_PLRU + 4096, O_SK = O_PLRUC + 12288, O_SV = O_SK + 4194304, O_SSSM = O_SV + 4194304,
                 O_SSSMC = O_SSSM + 4194304, O_SHG = O_SSSMC + 393216, O_SLRU = O_SHG + 4194304, O_SLRUC = O_SLRU + 65536, O_END = O_SLRUC + 196608;
constexpr int RING_BYTES = 131072, LDSCTL_OFF = RING_BYTES, MISC_OFF = LDSCTL_OFF + 320, SSQ_LDS_OFF = LDSCTL_OFF + 1024, WSCR_OFF = LDSCTL_OFF + 4096, PTAB_OFF = LDSCTL_OFF + 12288, LDS_BYTES = 147456;

typedef unsigned v2u __attribute__((ext_vector_type(2)));

__device__ __forceinline__ float bf2f(unsigned short u) { return __builtin_bit_cast(float, (unsigned)u << 16); }
__device__ __forceinline__ float bflo(unsigned u) { return __builtin_bit_cast(float, u << 16); }
__device__ __forceinline__ float bfhi(unsigned u) { return __builtin_bit_cast(float, u & 0xffff0000u); }
typedef float f32x2_t __attribute__((ext_vector_type(2))); typedef __bf16 bf16x2_t __attribute__((ext_vector_type(2)));
__device__ __forceinline__ unsigned cvtpk_(float lo, float hi) { f32x2_t v = {lo, hi}; bf16x2_t b = __builtin_convertvector(v, bf16x2_t); return __builtin_bit_cast(unsigned, b); }
__device__ __forceinline__ unsigned short f2bf_s(float f) { return (unsigned short)cvtpk_(f, 0.f); }
#define pk2(lo, hi) cvtpk_((lo), (hi))
template <int CTRL, int ROWMASK> __device__ __forceinline__ float dpp_add_(float v) {
    return v + __builtin_bit_cast(float, __builtin_amdgcn_update_dpp(0, __builtin_bit_cast(int, v), CTRL, ROWMASK, 0xF, true));
}
__device__ __forceinline__ float row16_sum(float v) {
    v = dpp_add_<0xB1, 0xF>(v); v = dpp_add_<0x4E, 0xF>(v); v = dpp_add_<0x141, 0xF>(v); v = dpp_add_<0x140, 0xF>(v); return v;
}
__device__ __forceinline__ float half32_sum_hi(float v) {
    return dpp_add_<0x142, 0xA>(row16_sum(v));
}
__device__ __forceinline__ float wave_sum(float v) {
    v = dpp_add_<0x143, 0xC>(half32_sum_hi(v));
    return __builtin_bit_cast(float, __builtin_amdgcn_readlane(__builtin_bit_cast(int, v), 63));
}
__device__ __forceinline__ float rdlane(float v, int l) { return __builtin_bit_cast(float, __builtin_amdgcn_readlane(__builtin_bit_cast(int, v), l)); }
__device__ __forceinline__ float rcpf_(float x) { return __builtin_amdgcn_rcpf(x); }
__device__ __forceinline__ float rsqf_(float x) { return __builtin_amdgcn_rsqf(x); }
__device__ __forceinline__ float sigmoidf_(float x) { return rcpf_(1.0f + __expf(-x)); }
__device__ __forceinline__ float siluf_(float x) { return x * rcpf_(1.0f + __expf(-x)); }
__device__ __forceinline__ float softplusf_(float x) { return x > 20.f ? x : log1pf(__expf(x)); }
__device__ __forceinline__ float geluf_(float x) { const float u = 0.7978845608028654f * (x + 0.044715f * x * x * x); return x * rcpf_(1.0f + __expf(-2.0f * u)); }
__device__ __forceinline__ float one_minus_exp_(float z) {
    const float ser = -z * (1.0f + z * (0.5f + z * (0.16666667f + z * (0.041666668f + z * 0.008333334f))));
    return z > -0.25f ? ser : 1.0f - __expf(z);
}
#define OPQ(p) asm volatile("" : "+v"(p))
__device__ __forceinline__ void ld64s_nt(float (&v)[64], const float* p) {
#pragma unroll
    for (int i0 = 0; i0 < 64; i0 += 8) {
#pragma unroll
        for (int i = 0; i < 8; ++i) v[i0 + i] = __builtin_nontemporal_load(p + i * 64);
        p += 512; OPQ(p); }
}
__device__ __forceinline__ void st64s_nt(const float (&v)[64], float* p) {
#pragma unroll
    for (int i0 = 0; i0 < 64; i0 += 8) {
#pragma unroll
        for (int i = 0; i < 8; ++i) __builtin_nontemporal_store(v[i0 + i], p + i * 64);
        p += 512; OPQ(p); }
}
__device__ __forceinline__ void ld64s(float (&v)[64], const float* p) {
#pragma unroll
    for (int i0 = 0; i0 < 64; i0 += 8) {
#pragma unroll
        for (int i = 0; i < 8; ++i) v[i0 + i] = p[i * 64];
        p += 512; OPQ(p); }
}
__device__ __forceinline__ void st64s(const float (&v)[64], float* p) {
#pragma unroll
    for (int i0 = 0; i0 < 64; i0 += 8) {
#pragma unroll
        for (int i = 0; i < 8; ++i) p[i * 64] = v[i0 + i];
        p += 512; OPQ(p); }
}
struct Frame {
    LAS unsigned char* lds;
    volatile LAS unsigned* MISC;
    gu32* ctl;
    int tid, lane, wave, vcu, G;
    float* out; unsigned char* ws;
};
__device__ __forceinline__ const float* pin_(LAS unsigned char* lds, int i) {
    const unsigned long long v = *(const volatile LAS unsigned long long*)(lds + PTAB_OFF + 8 * i);
    const unsigned lo = (unsigned)__builtin_amdgcn_readfirstlane((int)(unsigned)v), hi = (unsigned)__builtin_amdgcn_readfirstlane((int)(unsigned)(v >> 32));
    return (const float*)(GAS const float*)(((unsigned long long)hi << 32) | lo);
}
#define PIN(i) pin_(F.lds, (i))
enum { I_XP = 0, I_XS, I_CK, I_CV, I_SSSM, I_SSSMC, I_SHG, I_SLRU, I_SLRUC, I_NMIX, I_WIN, I_SCW, I_SCB, I_SDTB, I_SALOG, I_SD, I_SNW, I_SINK, I_RELB, I_HLB, I_HNW,
       I_LCW, I_LCB, I_LWA, I_LBA, I_LWX, I_LBX, I_LLAM, I_WOUT, I_NMLP, I_WUP, I_WDN, I_NF };

__device__ __forceinline__ void p0_transpose_item(const float* W, int K, int Nsrc, bf16* WT, int n_dst0, int n_src0, int k0, const float* scale, LAS float* scr, int lane) {
    float wv[32];
#pragma unroll
    for (int i = 0; i < 32; ++i) wv[i] = __builtin_nontemporal_load(W + (size_t)(k0 + 2 * i + (lane >> 5)) * Nsrc + n_src0 + (lane & 31));
#pragma unroll
    for (int i = 0; i < 32; ++i) { const int kk = 2 * i + (lane >> 5); const float sc = scale ? scale[k0 + kk] : 1.0f; scr[kk * 33 + (lane & 31)] = wv[i] * sc; }
    LDS_WAIT(); asm volatile("" ::: "memory");
    const int c = lane & 7;
    const __amdgpu_buffer_rsrc_t wrsrc = __builtin_amdgcn_make_buffer_rsrc((void*)WT, 0, 16 * 1024 * 1024, 0x00020000);
#pragma unroll
    for (int j = 0; j < 4; ++j) { const int n = (lane >> 3) + 8 * j; const LAS float* s = scr + (8 * c) * 33 + n;
        v4u o; o.x = pk2(s[0 * 33], s[1 * 33]); o.y = pk2(s[2 * 33], s[3 * 33]); o.z = pk2(s[4 * 33], s[5 * 33]); o.w = pk2(s[6 * 33], s[7 * 33]);
        __builtin_amdgcn_raw_buffer_store_b128(o, wrsrc, (unsigned)(((size_t)(n_dst0 + n) * K + k0 + 8 * c) * 2), 0, 16); }
    LDS_WAIT(); asm volatile("" ::: "memory");
}
__device__ __forceinline__ void p0_prologue(Frame& F) {
    LAS float* scr = (LAS float*)(F.lds + F.wave * 16384);
    const int gw = F.vcu * NWAVES + F.wave, NGW = F.G * NWAVES;
    constexpr int I_IN = 16 * 88, I_OUT = 16 * 32, I_UP = 16 * 128, I_DN = 64 * 32, I_L = I_IN + I_OUT + I_UP + I_DN;
    for (int it = gw; it < 2 * I_L; it += NGW) {
        const int l = it / I_L; int r = it % I_L;
        if (r < I_IN) { const int kb = r / 88, nb = r % 88, nd = 32 * nb, ns = nd < 768 ? nd : nd + 4;
            p0_transpose_item(PIN(I_WIN) + (size_t)l * D * NIN, D, NIN, (bf16*)(F.ws + WS_WIN) + (size_t)l * NPROJ * D, nd, ns, 64 * kb, PIN(I_NMIX) + l * D, scr, F.lane); continue; } r -= I_IN;
        if (r < I_OUT) { const int kb = r / 32, nb = r % 32;
            p0_transpose_item(PIN(I_WOUT) + (size_t)l * D * D, D, D, (bf16*)(F.ws + WS_WOUT) + (size_t)l * D * D, 32 * nb, 32 * nb, 64 * kb, nullptr, scr, F.lane); continue; } r -= I_OUT;
        if (r < I_UP) { const int kb = r / 128, nb = r % 128;
            p0_transpose_item(PIN(I_WUP) + (size_t)l * D * FF, D, FF, (bf16*)(F.ws + WS_WUP) + (size_t)l * FF * D, 32 * nb, 32 * nb, 64 * kb, PIN(I_NMLP) + l * D, scr, F.lane); continue; } r -= I_UP;
        { const int kb = r / 32, nb = r % 32;
            p0_transpose_item(PIN(I_WDN) + (size_t)l * FF * D, FF, D, (bf16*)(F.ws + WS_WDN) + (size_t)l * D * FF, 32 * nb, 32 * nb, 64 * kb, nullptr, scr, F.lane); }
    }
    for (int e = gw * 64 + F.lane; e < 2 * 4 * D; e += NGW * 64) { const int l = e / (4 * D), h = (e / D) % 4, k = e % D;
        ((float*)(F.ws + WS_WDT))[e] = PIN(I_NMIX)[l * D + k] * PIN(I_WIN)[(size_t)l * D * NIN + (size_t)k * NIN + 768 + h]; }
    for (int e = gw * 64 + F.lane; e < 2 * 2 * 4 * 4096; e += NGW * 64) { const int l = e >> 15, gate = (e >> 14) & 1, blk = (e >> 12) & 3, j = (e >> 6) & 63, i = e & 63;
        ((bf16*)(F.ws + WS_LWT))[e] = f2bf_s((gate ? PIN(I_LWX) : PIN(I_LWA))[(((size_t)l * 4 + blk) * 64 + i) * 64 + j]); }
    bf16* xb = (bf16*)(F.ws + WS_XB); float* ssq = (float*)(F.ws + WS_SSQA); float* dto = (float*)(F.ws + WS_DT);
    f32x4 wdt[4][4];
#pragma unroll
    for (int j = 0; j < 4; ++j)
#pragma unroll
        for (int e = 0; e < 4; ++e) { const int k = 256 * j + 4 * F.lane + e; wdt[j][e] = *(const f32x4*)(PIN(I_WIN) + (size_t)k * NIN + 768) * PIN(I_NMIX)[k]; }
    const float dtbias = PIN(I_SDTB)[F.lane & 3];
    for (int m0 = gw; m0 < M; m0 += 2 * NGW) {
        f32x4 v[2][4];
#pragma unroll
        for (int rr = 0; rr < 2; ++rr) { const int m = (m0 + rr * NGW < M) ? m0 + rr * NGW : m0;
            const float* xrow = (m < MP) ? PIN(I_XP) + (size_t)m * D : PIN(I_XS) + (size_t)(m - MP) * D;
#pragma unroll
            for (int j = 0; j < 4; ++j) v[rr][j] = __builtin_nontemporal_load((const f32x4*)xrow + F.lane + 64 * j); }
#pragma unroll
        for (int rr = 0; rr < 2; ++rr) { const int m = m0 + rr * NGW; if (m >= M) break;
            float s = 0.f; unsigned long long* o8 = (unsigned long long*)(xb + (size_t)m * D) + F.lane;
#pragma unroll
            for (int j = 0; j < 4; ++j) { const f32x4 q = v[rr][j]; s += (q.x * q.x + q.y * q.y) + (q.z * q.z + q.w * q.w);
                o8[64 * j] = (unsigned long long)pk2(q.x, q.y) | ((unsigned long long)pk2(q.z, q.w) << 32); }
            s = wave_sum(s);
            if (F.lane < 16) ssq[(size_t)m * 16 + F.lane] = (F.lane == 0) ? s : 0.f;
            f32x4 dd = {0.f, 0.f, 0.f, 0.f};
#pragma unroll
            for (int j = 0; j < 4; ++j) { const f32x4 q = v[rr][j]; dd += wdt[j][0] * q.x + wdt[j][1] * q.y + wdt[j][2] * q.z + wdt[j][3] * q.w; }
            const float d0 = wave_sum(dd.x), d1 = wave_sum(dd.y), d2 = wave_sum(dd.z), d3 = wave_sum(dd.w);
            const float rs = rsqf_(s * (1.0f / D) + EPS);
            const float dsel = (F.lane & 3) == 0 ? d0 : (F.lane & 3) == 1 ? d1 : (F.lane & 3) == 2 ? d2 : d3;
            if (F.lane < 4) dto[(size_t)m * 4 + F.lane] = softplusf_(dsel * rs + dtbias); }
    }
}
__device__ __forceinline__ void final_norm(Frame& F) {
    const int gw = F.vcu * NWAVES + F.wave, NGW = F.G * NWAVES;
    const float* ssq = (const float*)(F.ws + WS_SSQA);
    f32x4 wv[4];
#pragma unroll
    for (int j = 0; j < 4; ++j) wv[j] = ((const f32x4*)PIN(I_NF) + F.lane)[64 * j];
#pragma unroll 1
    for (int m0 = (NGW - 1 - gw); m0 < MP; m0 += 4 * NGW) {
        f32x4 v[4][4]; float sq[4];
#pragma unroll
        for (int rr = 0; rr < 4; ++rr) { const int m = (m0 + rr * NGW < MP) ? m0 + rr * NGW : m0; sq[rr] = ssq[(size_t)m * 16 + (F.lane & 15)];
#pragma unroll
            for (int j = 0; j < 4; ++j) { const v2u u = __builtin_nontemporal_load((const v2u*)((const bf16*)(F.ws + WS_XB) + (size_t)m * D) + F.lane + 64 * j); v[rr][j] = (f32x4){bflo(u.x), bfhi(u.x), bflo(u.y), bfhi(u.y)}; } }
#pragma unroll
        for (int rr = 0; rr < 4; ++rr) { const int m = m0 + rr * NGW; if (m >= MP) break;
            float s = sq[rr]; s = row16_sum(s);
            const float rs = rsqf_(s * (1.0f / D) + EPS);
#pragma unroll
            for (int j = 0; j < 4; ++j) __builtin_nontemporal_store(v[rr][j] * rs * wv[j], (f32x4*)(F.out + (size_t)m * D) + F.lane + 64 * j); }
    }
}

constexpr int G4_KP = 8;
template <bool FINAL> __device__ __forceinline__ void sample_reduce(Frame& F) {
    const int gw = F.vcu * NWAVES + F.wave, NGW = F.G * NWAVES, lane = F.lane;
    const bf16* slab = (const bf16*)(F.ws + WS_MIX); bf16* xb = (bf16*)(F.ws + WS_XB); float* ssq = (float*)(F.ws + WS_SSQA);
    f32x4 wdt[4][4];
    float dtbias = 0.f;
    if (!FINAL) {
#pragma unroll
        for (int j = 0; j < 4; ++j)
#pragma unroll
            for (int h = 0; h < 4; ++h) wdt[j][h] = *(const f32x4*)((const float*)(F.ws + WS_WDT) + (size_t)(4 + h) * D + 256 * j + 4 * lane);
        dtbias = PIN(I_SDTB)[4 + (lane & 3)];
    }
    for (int rs = gw; rs < MS; rs += NGW) {
        const int pmr = rs >> 8, rr = rs & 255, row = MP + rs;
        f32x4 acc[4]; float* xrow = F.out + (size_t)row * D;
#pragma unroll
        for (int j = 0; j < 4; ++j) { const v2u u = *(const v2u*)(xb + (size_t)row * D + j * 256 + lane * 4); acc[j] = (f32x4){bflo(u.x), bfhi(u.x), bflo(u.y), bfhi(u.y)}; }
#pragma unroll
        for (int j = 0; j < 4; ++j)
#pragma unroll
            for (int kp = 0; kp < G4_KP; ++kp) { const v2u u = __builtin_nontemporal_load((const v2u*)(slab + (size_t)((pmr * 4 + j) * G4_KP + kp) * 65536 + rr * 256 + lane * 4)); acc[j] += (f32x4){bflo(u.x), bfhi(u.x), bflo(u.y), bfhi(u.y)}; }
        float s = 0.f;
#pragma unroll
        for (int j = 0; j < 4; ++j) { const f32x4 v = acc[j]; s += (v.x * v.x + v.y * v.y) + (v.z * v.z + v.w * v.w); }
        s = wave_sum(s);
        if (FINAL) {
            const float rsn = rsqf_(s * (1.0f / D) + EPS);
#pragma unroll
            for (int j = 0; j < 4; ++j) __builtin_nontemporal_store(acc[j] * rsn * *(const f32x4*)(PIN(I_NF) + j * 256 + lane * 4), (f32x4*)(xrow + j * 256 + lane * 4));
        } else {
#pragma unroll
            for (int j = 0; j < 4; ++j) { const f32x4 v = acc[j];
                v2u o; o.x = pk2(v.x, v.y); o.y = pk2(v.z, v.w); *(v2u*)(xb + (size_t)row * D + j * 256 + lane * 4) = o; }
            if (lane < 16) ssq[(size_t)row * 16 + lane] = (lane == 0) ? s : 0.f;
            float d[4];
#pragma unroll
            for (int h = 0; h < 4; ++h) { float t = 0.f;
#pragma unroll
                for (int j = 0; j < 4; ++j) { const f32x4 p = acc[j] * wdt[j][h]; t += (p.x + p.y) + (p.z + p.w); }
                d[h] = wave_sum(t); }
            const float dsel = (lane & 3) == 0 ? d[0] : (lane & 3) == 1 ? d[1] : (lane & 3) == 2 ? d[2] : d[3];
            if (lane < 4) ((float*)(F.ws + WS_DT))[(size_t)row * 4 + lane] = softplusf_(dsel * rsqf_(s * (1.0f / D) + EPS) + dtbias);
        }
    }
}
__device__ __forceinline__ void dt_pass(Frame& F, int l, int MR) {
    const int gw = F.vcu * NWAVES + F.wave, NGW = F.G * NWAVES, lane = F.lane;
    const bf16* xb = (const bf16*)(F.ws + WS_XB); const float* ssq = (const float*)(F.ws + WS_SSQA); float* dto = (float*)(F.ws + WS_DT);
    const float* wd = (const float*)(F.ws + WS_WDT) + (size_t)l * 4 * D + lane * 16;
    float w[4][16];
#pragma unroll
    for (int h = 0; h < 4; ++h)
#pragma unroll
        for (int i = 0; i < 16; i += 4) { const f32x4 v = *(const f32x4*)(wd + h * D + i); w[h][i] = v.x; w[h][i + 1] = v.y; w[h][i + 2] = v.z; w[h][i + 3] = v.w; }
    const float bias = PIN(I_SDTB)[l * 4 + (lane & 3)];
#pragma unroll 1
    for (int m0 = gw; m0 < MR; m0 += 4 * NGW) {
        v4u a[4], b[4]; float sq[4];
#pragma unroll
        for (int r = 0; r < 4; ++r) { const int m = m0 + r * NGW < MR ? m0 + r * NGW : m0;
            a[r] = *(const v4u*)(xb + (size_t)m * D + lane * 16); b[r] = *(const v4u*)(xb + (size_t)m * D + lane * 16 + 8); sq[r] = ssq[(size_t)m * 16 + (lane & 15)]; }
#pragma unroll
        for (int r = 0; r < 4; ++r) {
            const int m = m0 + r * NGW;
            float x[16] = {bflo(a[r].x), bfhi(a[r].x), bflo(a[r].y), bfhi(a[r].y), bflo(a[r].z), bfhi(a[r].z), bflo(a[r].w), bfhi(a[r].w),
                           bflo(b[r].x), bfhi(b[r].x), bflo(b[r].y), bfhi(b[r].y), bflo(b[r].z), bfhi(b[r].z), bflo(b[r].w), bfhi(b[r].w)};
            float d[4];
#pragma unroll
            for (int h = 0; h < 4; ++h) { float s = 0.f;
#pragma unroll
                for (int i = 0; i < 16; ++i) s += x[i] * w[h][i];
                d[h] = wave_sum(s); }
            float q = sq[r]; q = row16_sum(q);
            const float rs = rsqf_(q * (1.0f / D) + EPS);
            const float dsel = (lane & 3) == 0 ? d[0] : (lane & 3) == 1 ? d[1] : (lane & 3) == 2 ? d[2] : d[3];
            if (lane < 4 && m < MR) dto[(size_t)m * 4 + lane] = softplusf_(dsel * rs + bias);
        }
    }
}

__device__ __forceinline__ float row_rstd(const float* ssq, int row, int lane) {
    float s = ssq[(size_t)row * 16 + (lane & 15)]; s = row16_sum(s);
    return rsqf_(s * (1.0f / D) + EPS);
}
#define PROJ(F) ((const bf16*)((F).ws + WS_PROJ))
template <bool WRITE_Y>
__device__ __forceinline__ void ssd_wave(Frame& F, int l, int h, int row0, int nsteps, int hist, const float* cs, float (&S)[64], float& logdec,
                                         LAS float* ylds  , LAS float* ssql  ) {
    const int lane = F.lane, g = h >> 1;
    const int cx = h * 64 + lane, cB = 256 + g * 64 + lane, cC = 384 + g * 64 + lane;
    const float* cw = PIN(I_SCW) + (size_t)l * 4 * 512; const float* cb = PIN(I_SCB) + (size_t)l * 512;
    float wx[4], wB[4], wC[4];
#pragma unroll
    for (int k = 0; k < 4; ++k) { wx[k] = cw[k * 512 + cx]; wB[k] = cw[k * 512 + cB]; wC[k] = cw[k * 512 + cC]; }
    const float bx = cb[cx], bB = cb[cB], bC = cb[cC];
    const float A = -__expf(PIN(I_SALOG)[l * 4 + h]), Dh = PIN(I_SD)[l * 4 + h];
    const bf16* proj = PROJ(F);
    const float dtv = (lane < nsteps) ? ((const float*)(F.ws + WS_DT))[(size_t)(row0 + lane) * 4 + h] : 0.f;
    float x1 = 0.f, x2 = 0.f, x3 = 0.f, B1 = 0.f, B2 = 0.f, B3 = 0.f, C1 = 0.f, C2 = 0.f, C3 = 0.f;
    if (hist == 1) {
        const bf16* p = proj + (size_t)(row0 - 1) * NPROJ + 256;
        x1 = bf2f(p[cx]); B1 = bf2f(p[cB]); C1 = bf2f(p[cC]); p -= NPROJ; x2 = bf2f(p[cx]); B2 = bf2f(p[cB]); C2 = bf2f(p[cC]); p -= NPROJ; x3 = bf2f(p[cx]); B3 = bf2f(p[cB]); C3 = bf2f(p[cC]);
    } else if (hist == 2) {
        x3 = cs[cx]; B3 = cs[cB]; C3 = cs[cC]; x2 = cs[512 + cx]; B2 = cs[512 + cB]; C2 = cs[512 + cC]; x1 = cs[1024 + cx]; B1 = cs[1024 + cB]; C1 = cs[1024 + cC];
    }
    LAS float* bc = (LAS float*)(F.lds + WSCR_OFF) + F.wave * 256;
    const int last = nsteps - 1;
#define SSD_LOAD(xv, Bv, Cv, zv, tt) do { const bf16* p_ = proj + (size_t)(row0 + ((tt) < last ? (tt) : last)) * NPROJ; xv = bf2f(p_[256 + cx]); Bv = bf2f(p_[256 + cB]); Cv = bf2f(p_[256 + cC]); zv = WRITE_Y ? bf2f(p_[cx]) : 0.f; } while (0)
    float xa, Ba, Ca, za, xn, Bn, Cn, zn, xm, Bm, Cm, zm;
    SSD_LOAD(xa, Ba, Ca, za, 0); SSD_LOAD(xn, Bn, Cn, zn, 1);
#pragma unroll 4
    for (int t = 0; t < nsteps; ++t) {
        SSD_LOAD(xm, Bm, Cm, zm, t + 2);
        const float xc = bx + wx[0] * x3 + wx[1] * x2 + wx[2] * x1 + wx[3] * xa; x3 = x2; x2 = x1; x1 = xa;
        const float Bc = bB + wB[0] * B3 + wB[1] * B2 + wB[2] * B1 + wB[3] * Ba; B3 = B2; B2 = B1; B1 = Ba;
        const float Cc = bC + wC[0] * C3 + wC[1] * C2 + wC[2] * C1 + wC[3] * Ca; C3 = C2; C2 = C1; C1 = Ca;
        const float xs = siluf_(xc);
        bc[lane] = siluf_(Bc); if (WRITE_Y) bc[64 + lane] = siluf_(Cc);
        const float dt = rdlane(dtv, t), dA = __expf(dt * A), xdt = xs * dt;
        logdec += dt * A;
        float y0 = 0.f, y1 = 0.f;
#pragma unroll
        for (int n = 0; n < 64; n += 4) {
            const f32x4 bv = *(const LAS f32x4*)(bc + n);
            S[n] = dA * S[n] + xdt * bv.x; S[n + 1] = dA * S[n + 1] + xdt * bv.y; S[n + 2] = dA * S[n + 2] + xdt * bv.z; S[n + 3] = dA * S[n + 3] + xdt * bv.w;
            if (WRITE_Y) { const f32x4 cv = *(const LAS f32x4*)(bc + 64 + n); y0 += S[n] * cv.x + S[n + 2] * cv.z; y1 += S[n + 1] * cv.y + S[n + 3] * cv.w; }
        }
        if (WRITE_Y) {
            const float yg = ((y0 + y1) + Dh * xs) * siluf_(za);
            ylds[t * 256 + cx] = yg;
            const float q = wave_sum(yg * yg);
            if (lane == 0) ssql[t * 4 + h] = q;
        }
        xa = xn; Ba = Bn; Ca = Cn; za = zn; xn = xm; Bn = Bm; Cn = Cm; zn = zm;
    }
#undef SSD_LOAD
}
__device__ __forceinline__ void ssd_norm_store(Frame& F, int l, int h, int row0, int nsteps, const LAS float* ylds, const LAS float* ssql) {
    const int cx = h * 64 + F.lane; const float nw = PIN(I_SNW)[l * 256 + cx];
    bf16* mix = (bf16*)(F.ws + WS_MIX);
#pragma unroll 8
    for (int t = 0; t < nsteps; ++t) {
        const float q = (ssql[t * 4] + ssql[t * 4 + 1]) + (ssql[t * 4 + 2] + ssql[t * 4 + 3]);
        const float rs = rsqf_(q * (1.0f / 256.0f) + EPS);
        mix[(size_t)(row0 + t) * D + cx] = f2bf_s(ylds[t * 256 + cx] * rs * nw);
    }
}
__device__ __forceinline__ void ssd_conv_out(Frame& F, int h, int r0, float* dst) {
    const bf16* proj = PROJ(F); const int lane = F.lane, g = h >> 1;
#pragma unroll
    for (int j = 0; j < 3; ++j) { const bf16* p = proj + (size_t)(r0 + j) * NPROJ + 256; dst[j * 512 + h * 64 + lane] = bf2f(p[h * 64 + lane]);
        if ((h & 1) == 0) { dst[j * 512 + 256 + g * 64 + lane] = bf2f(p[256 + g * 64 + lane]); dst[j * 512 + 384 + g * 64 + lane] = bf2f(p[384 + g * 64 + lane]); } }
}
__device__ __forceinline__ void ssd_item(Frame& F, int l, int kind, int it) {
#ifdef SKIP_SSD
    return;
#endif
    const int w = F.wave, h = w & 3, half = w >> 2, lane = F.lane;
    LAS float* ylds = (LAS float*)F.lds + half * (64 * 256); LAS float* ssql = (LAS float*)(F.lds + SSQ_LDS_OFF) + half * 256;
    float* sloc = (float*)(F.ws + WS_SSDLOC); float* decS = (float*)(F.ws + WS_SMALL);
    float S[64]; float logdec = 0.f;
#pragma unroll
    for (int n = 0; n < 64; ++n) S[n] = 0.f;
    if (kind == 2) {
        const int b = it * 2 + half, row0 = MP + b * SL;
        const float* st = PIN(I_SSSM) + (((size_t)l * SB + b) * 4 + h) * 4096 + lane * 64;
#pragma unroll
        for (int n = 0; n < 64; n += 4) { const f32x4 v = *(const f32x4*)(st + n); S[n] = v.x; S[n + 1] = v.y; S[n + 2] = v.z; S[n + 3] = v.w; }
        ssd_wave<true>(F, l, h, row0, SL, 2, PIN(I_SSSMC) + ((size_t)l * SB + b) * 1536, S, logdec, ylds, ssql);
        float* so = F.out + O_SSSM + (((size_t)l * SB + b) * 4 + h) * 4096 + lane * 64;
#pragma unroll
        for (int n = 0; n < 64; n += 4) *(f32x4*)(so + n) = (f32x4){S[n], S[n + 1], S[n + 2], S[n + 3]};
        ssd_conv_out(F, h, row0 + SL - 3, F.out + O_SSSMC + ((size_t)l * SB + b) * 1536);
        __syncthreads();
        ssd_norm_store(F, l, h, row0, SL, ylds, ssql);
        __syncthreads();
        return;
    }
    const int b = it / 16, c = (it % 16) * 2 + half, row0 = b * SEQ + c * 64, sidx = (b * 4 + h) * NCH + c;
    if (kind == 0) {
        ssd_wave<false>(F, l, h, row0, 64, c == 0 ? 0 : 1, nullptr, S, logdec, ylds, ssql);
        st64s(S, sloc + (size_t)sidx * 4096 + lane);
        if (lane == 0) decS[sidx] = __expf(logdec);
        return;
    }
    ld64s(S, sloc + (size_t)sidx * 4096 + lane);
    ssd_wave<true>(F, l, h, row0, 64, c == 0 ? 0 : 1, nullptr, S, logdec, ylds, ssql);
    if (c == NCH - 1) {
        float* so = F.out + O_PSSM + (((size_t)l * NB + b) * 4 + h) * 4096 + lane * 64;
#pragma unroll
        for (int n = 0; n < 64; n += 4) *(f32x4*)(so + n) = (f32x4){S[n], S[n + 1], S[n + 2], S[n + 3]};
        ssd_conv_out(F, h, row0 + 61, F.out + O_PSSMC + ((size_t)l * NB + b) * 1536);
    }
    __syncthreads();
    ssd_norm_store(F, l, h, row0, 64, ylds, ssql);
    __syncthreads();
}

template <bool WRITE_Y>
__device__ __forceinline__ void hgrn_wave(Frame& F, int l, int h, int row0, int nsteps, float (&S)[64], float& decv) {
    const int lane = F.lane, ch = h * 64 + lane;
    const float lbk = (l == 0) ? 0.f : sigmoidf_(PIN(I_HLB)[256 + ch] - PIN(I_HLB)[ch]);
    const float nw = PIN(I_HNW)[l * 256 + ch];
    const bf16* proj = PROJ(F); bf16* mix = (bf16*)(F.ws + WS_MIX);
    LAS float* bc = (LAS float*)(F.lds + WSCR_OFF) + F.wave * 256;
    const int last = nsteps - 1;
#define HG_LOAD(qv_, fv_, iv_, gv_, tt) do { const bf16* p_ = proj + (size_t)(row0 + ((tt) < last ? (tt) : last)) * NPROJ + ch; qv_ = bf2f(p_[1280]); fv_ = bf2f(p_[1536]); iv_ = bf2f(p_[1792]); gv_ = WRITE_Y ? bf2f(p_[2048]) : 0.f; } while (0)
    float qa, fa, ia, ga, qn, fn, in_, gn, qm, fm, im, gm;
    HG_LOAD(qa, fa, ia, ga, 0); HG_LOAD(qn, fn, in_, gn, 1);
#pragma unroll 4
    for (int t = 0; t < nsteps; ++t) {
        HG_LOAD(qm, fm, im, gm, t + 2);
        const float sg = sigmoidf_(fa), f = lbk + (1.0f - lbk) * sg, kk = (1.0f - lbk) * (1.0f - sg), iv = ia;
        decv *= f;
        bc[lane] = f; bc[64 + lane] = kk; if (WRITE_Y) bc[128 + lane] = qa;
        float o0 = 0.f, o1 = 0.f;
#pragma unroll
        for (int k = 0; k < 64; k += 4) {
            const f32x4 fv = *(const LAS f32x4*)(bc + k), kv = *(const LAS f32x4*)(bc + 64 + k);
            S[k] = fv.x * S[k] + kv.x * iv; S[k + 1] = fv.y * S[k + 1] + kv.y * iv; S[k + 2] = fv.z * S[k + 2] + kv.z * iv; S[k + 3] = fv.w * S[k + 3] + kv.w * iv;
            if (WRITE_Y) { const f32x4 qv = *(const LAS f32x4*)(bc + 128 + k); o0 += qv.x * S[k] + qv.z * S[k + 2]; o1 += qv.y * S[k + 1] + qv.w * S[k + 3]; }
        }
        if (WRITE_Y) {
            const float o = o0 + o1; const float ms = wave_sum(o * o) * (1.0f / 64.0f);
            mix[(size_t)(row0 + t) * D + 512 + ch] = f2bf_s(o * (rsqf_(ms + EPS)) * nw * sigmoidf_(ga));
        }
        qa = qn; fa = fn; ia = in_; ga = gn; qn = qm; fn = fm; in_ = im; gn = gm;
    }
#undef HG_LOAD
}
__device__ __forceinline__ void hgrn_item(Frame& F, int l, int kind, int wi) {
#ifdef SKIP_HG
    return;
#endif
    const int lane = F.lane;
    float* sloc = (float*)(F.ws + WS_HGLOC); float* decH = (float*)(F.ws + WS_SMALL) + 1024;
    float S[64]; float decv = 1.0f;
#pragma unroll
    for (int k = 0; k < 64; ++k) S[k] = 0.f;
    if (kind == 2) {
        const int b = wi >> 2, h = wi & 3, row0 = MP + b * SL;
        ld64s_nt(S, PIN(I_SHG) + (((size_t)l * SB + b) * 4 + h) * 4096 + lane);
        hgrn_wave<true>(F, l, h, row0, SL, S, decv);
        st64s_nt(S, F.out + O_SHG + (((size_t)l * SB + b) * 4 + h) * 4096 + lane);
        return;
    }
    const int b = wi / 128, h = (wi / 32) % 4, c = wi % 32, row0 = b * SEQ + c * 64, sidx = (b * 4 + h) * NCH + c;
    if (kind == 0) {
        hgrn_wave<false>(F, l, h, row0, 64, S, decv);
        st64s(S, sloc + (size_t)sidx * 4096 + lane);
        decH[(size_t)sidx * 64 + lane] = decv;
        return;
    }
    ld64s(S, sloc + (size_t)sidx * 4096 + lane);
    hgrn_wave<true>(F, l, h, row0, 64, S, decv);
    if (c == NCH - 1) {
        st64s(S, F.out + O_PHG + (((size_t)l * NB + b) * 4 + h) * 4096 + lane);
    }
}

template <bool WRITE_Y>
__device__ __forceinline__ void lru_wave(Frame& F, int l, int blk, int row0, int nsteps, int hist, const float* cs  , float& hst, float& aprod) {
    const int lane = F.lane, ch = blk * 64 + lane;
    const float* cw = PIN(I_LCW) + (size_t)l * 4 * 256; const float cb = PIN(I_LCB)[l * 256 + ch];
    const float w0 = cw[ch], w1 = cw[256 + ch], w2 = cw[512 + ch], w3 = cw[768 + ch];
    const float sp = softplusf_(-PIN(I_LLAM)[l * 256 + ch]);
    const bf16* proj = PROJ(F); bf16* mix = (bf16*)(F.ws + WS_MIX);
    LAS float* bc = (LAS float*)(F.lds + WSCR_OFF) + F.wave * 256;
    LAS float* la = (LAS float*)F.lds + F.wave * 4096;
    const int last = nsteps - 1;
    float h1 = 0.f, h2 = 0.f, h3 = 0.f;
    if (hist == 1) { const bf16* p = proj + (size_t)(row0 - 1) * NPROJ + 2304 + ch; h1 = bf2f(p[0]); h2 = bf2f(p[-NPROJ]); h3 = bf2f(p[-2 * NPROJ]); }
    else if (hist == 2) { h3 = cs[ch]; h2 = cs[256 + ch]; h1 = cs[512 + ch]; }
    float wg[64];
#define LRU_LOAD(xv_, gv_, tt, GATE) do { const bf16* p_ = proj + (size_t)(row0 + ((tt) < last ? (tt) : last)) * NPROJ + ch; xv_ = bf2f(p_[2304]); gv_ = (GATE) ? bf2f(p_[2560]) : 0.f; } while (0)
    ld64s(wg, PIN(I_LWA) + ((size_t)(l * 4 + blk) * 64) * 64 + lane);
    {
        const float ba = PIN(I_LBA)[l * 256 + ch];
        float x1 = h1, x2 = h2, x3 = h3, xa, ga, xn, gn, xm, gm;
        LRU_LOAD(xa, ga, 0, false); LRU_LOAD(xn, gn, 1, false);
#pragma unroll 4
        for (int t = 0; t < nsteps; ++t) {
            LRU_LOAD(xm, gm, t + 2, false);
            const float xc = cb + w0 * x3 + w1 * x2 + w2 * x1 + w3 * xa; x3 = x2; x2 = x1; x1 = xa;
            bc[lane] = xc;
            float r0 = ba, r1 = 0.f;
#pragma unroll
            for (int k = 0; k < 64; k += 4) { const f32x4 xv = *(const LAS f32x4*)(bc + k); r0 += xv.x * wg[k] + xv.z * wg[k + 2]; r1 += xv.y * wg[k + 1] + xv.w * wg[k + 3]; }
            la[t * 64 + lane] = -8.0f * sigmoidf_(r0 + r1) * sp;
            xa = xn; xn = xm; (void)ga; (void)gn; (void)gm;
        }
    }
    ld64s(wg, PIN(I_LWX) + ((size_t)(l * 4 + blk) * 64) * 64 + lane);
    {
        const float bxx = PIN(I_LBX)[l * 256 + ch];
        float x1 = h1, x2 = h2, x3 = h3, xa, ga, xn, gn, xm, gm;
        LRU_LOAD(xa, ga, 0, WRITE_Y); LRU_LOAD(xn, gn, 1, WRITE_Y);
#pragma unroll 4
        for (int t = 0; t < nsteps; ++t) {
            LRU_LOAD(xm, gm, t + 2, WRITE_Y);
            const float xc = cb + w0 * x3 + w1 * x2 + w2 * x1 + w3 * xa; x3 = x2; x2 = x1; x1 = xa;
            bc[lane] = xc;
            float r0 = bxx, r1 = 0.f;
#pragma unroll
            for (int k = 0; k < 64; k += 4) { const f32x4 xv = *(const LAS f32x4*)(bc + k); r0 += xv.x * wg[k] + xv.z * wg[k + 2]; r1 += xv.y * wg[k + 1] + xv.w * wg[k + 3]; }
            const float ig = sigmoidf_(r0 + r1), log_a = la[t * 64 + lane];
            const float a = __expf(log_a), u = __builtin_amdgcn_sqrtf(one_minus_exp_(2.0f * log_a)) * (ig * xc);
            hst = a * hst + u; aprod *= a;
            if (WRITE_Y) mix[(size_t)(row0 + t) * D + 768 + ch] = f2bf_s(hst * geluf_(ga));
            xa = xn; ga = gn; xn = xm; gn = gm;
        }
    }
#undef LRU_LOAD
}
__device__ __forceinline__ void lru_item(Frame& F, int l, int kind, int wi) {
#ifdef SKIP_LRU
    return;
#endif
    const int lane = F.lane; const bf16* proj = PROJ(F);
    float* lruH = (float*)(F.ws + WS_SMALL) + 1024 + 65536; float* lruA = lruH + 65536;
    float hst = 0.f, aprod = 1.0f;
    if (kind == 2) {
        const int b = wi >> 2, blk = wi & 3, ch = blk * 64 + lane, row0 = MP + b * SL;
        hst = PIN(I_SLRU)[((size_t)l * SB + b) * 256 + ch];
        lru_wave<true>(F, l, blk, row0, SL, 2, PIN(I_SLRUC) + ((size_t)l * SB + b) * 768, hst, aprod);
        F.out[O_SLRU + ((size_t)l * SB + b) * 256 + ch] = hst;
#pragma unroll
        for (int j = 0; j < 3; ++j) F.out[O_SLRUC + ((size_t)l * SB + b) * 768 + j * 256 + ch] = bf2f(proj[(size_t)(row0 + SL - 3 + j) * NPROJ + 2304 + ch]);
        return;
    }
    const int b = wi / 128, c = (wi / 4) % 32, blk = wi % 4, ch = blk * 64 + lane, row0 = b * SEQ + c * 64;
    if (kind == 0) {
        lru_wave<false>(F, l, blk, row0, 64, c == 0 ? 0 : 1, nullptr, hst, aprod);
        lruH[(size_t)(b * NCH + c) * 256 + ch] = hst; lruA[(size_t)(b * NCH + c) * 256 + ch] = aprod;
        return;
    }
    hst = lruH[(size_t)(b * NCH + c) * 256 + ch];
    lru_wave<true>(F, l, blk, row0, 64, c == 0 ? 0 : 1, nullptr, hst, aprod);
    if (c == NCH - 1) {
        F.out[O_PLRU + ((size_t)l * NB + b) * 256 + ch] = hst;
#pragma unroll
        for (int j = 0; j < 3; ++j) F.out[O_PLRUC + ((size_t)l * NB + b) * 768 + j * 256 + ch] = bf2f(proj[(size_t)(row0 + 61 + j) * NPROJ + 2304 + ch]);
    }
}

__device__ __forceinline__ int t5_bucket(int n) {
    if (n < 16) return n;
    const int v = 16 + (int)(__log2f((float)n * (1.0f / 16.0f)) * (16.0f / 3.0f));
    return v < 31 ? v : 31;
}
template <bool SAMPLE>
__device__ __forceinline__ void swa_item(Frame& F, int l, int it) {
#ifdef SKIP_SWA
    return;
#endif
    constexpr int NQ = SAMPLE ? 8 : 32, R = 2 * NQ, SUBS = 512 / R, NK = SAMPLE ? 136 : 160, KPS = (NK + SUBS - 1) / SUBS, OFF = SAMPLE ? 128 : 127, DPT = 64 / SUBS;
    constexpr int KS = 68, PS = 161;
    LAS float* Kl = (LAS float*)F.lds; LAS float* Vl = Kl + 160 * KS; LAS float* Pl = Vl + 160 * KS; LAS float* Bl = Pl + 64 * PS;
    const int tid = F.tid; const bf16* proj = PROJ(F);
    int b, kvh, t0, seqrow0;
    if (SAMPLE) { b = it >> 1; kvh = it & 1; t0 = 0; seqrow0 = MP + b * SL; }
    else { b = it / 128; kvh = (it / 64) & 1; t0 = (it % 64) * 32; seqrow0 = b * SEQ; }
    if (tid < 256) { const int qh = tid >> 7, df = tid & 127; Bl[tid] = PIN(I_RELB)[t5_bucket(df) * 4 + kvh * 2 + qh]; }
#pragma unroll
    for (int e = tid; e < NK * 8; e += 512) {
        const int j = e >> 3, sg = e & 7;
        f32x4 k0 = {0.f, 0.f, 0.f, 0.f}, k1 = k0, v0 = k0, v1 = k0;
        if (SAMPLE && j < 128) {
            const size_t o = ((((size_t)l * SB + b) * 128 + j) * 2 + kvh) * 64 + sg * 8;
            k0 = __builtin_nontemporal_load((const f32x4*)(PIN(I_CK) + o)); k1 = __builtin_nontemporal_load((const f32x4*)(PIN(I_CK) + o + 4)); v0 = __builtin_nontemporal_load((const f32x4*)(PIN(I_CV) + o)); v1 = __builtin_nontemporal_load((const f32x4*)(PIN(I_CV) + o + 4));
        } else {
            const int kp = SAMPLE ? (j - 128) : (t0 - 127 + j);
            if (kp >= 0 && kp < (SAMPLE ? SL : t0 + NQ)) {
                const bf16* p = proj + (size_t)(seqrow0 + kp) * NPROJ + kvh * 64 + sg * 8;
                const v4u ku = *(const v4u*)(p + 1024), vu = *(const v4u*)(p + 1152);
                k0 = (f32x4){bflo(ku.x), bfhi(ku.x), bflo(ku.y), bfhi(ku.y)}; k1 = (f32x4){bflo(ku.z), bfhi(ku.z), bflo(ku.w), bfhi(ku.w)};
                v0 = (f32x4){bflo(vu.x), bfhi(vu.x), bflo(vu.y), bfhi(vu.y)}; v1 = (f32x4){bflo(vu.z), bfhi(vu.z), bflo(vu.w), bfhi(vu.w)};
            }
        }
        *(LAS f32x4*)(Kl + j * KS + sg * 8) = k0; *(LAS f32x4*)(Kl + j * KS + sg * 8 + 4) = k1;
        *(LAS f32x4*)(Vl + j * KS + sg * 8) = v0; *(LAS f32x4*)(Vl + j * KS + sg * 8 + 4) = v1;
    }
    const int r = tid / SUBS, sub = tid % SUBS, qh = r / NQ, tq = r % NQ, head = kvh * 2 + qh;
    const int qrow = seqrow0 + t0 + tq;
    float q[64];
    { const bf16* p = proj + (size_t)qrow * NPROJ + 768 + head * 64;
#pragma unroll
      for (int i = 0; i < 8; ++i) { const v4u u = *(const v4u*)(p + i * 8);
          q[i * 8 + 0] = bflo(u.x) * 0.125f; q[i * 8 + 1] = bfhi(u.x) * 0.125f; q[i * 8 + 2] = bflo(u.y) * 0.125f; q[i * 8 + 3] = bfhi(u.y) * 0.125f;
          q[i * 8 + 4] = bflo(u.z) * 0.125f; q[i * 8 + 5] = bfhi(u.z) * 0.125f; q[i * 8 + 6] = bflo(u.w) * 0.125f; q[i * 8 + 7] = bfhi(u.w) * 0.125f; } }
    const float sink = PIN(I_SINK)[l * 4 + head];
    __syncthreads();
    float s[KPS]; float mx = sink;
#pragma unroll
    for (int i = 0; i < KPS; ++i) {
        const int j = sub + SUBS * i; const int jj = j < NK ? j : NK - 1;
        const LAS float* kr = Kl + jj * KS;
        float a0 = 0.f, a1 = 0.f;
#pragma unroll
        for (int d = 0; d < 64; d += 4) { const f32x4 kv = *(const LAS f32x4*)(kr + d); a0 += q[d] * kv.x + q[d + 2] * kv.z; a1 += q[d + 1] * kv.y + q[d + 3] * kv.w; }
        const int df = tq + OFF - j; const int kp = SAMPLE ? 0 : (t0 - 127 + j);
        const bool valid = (j < NK) && (df >= 0) && (df < 128) && (kp >= 0);
        s[i] = valid ? (a0 + a1) + Bl[qh * 128 + (df & 127)] : -INFINITY;
        mx = fmaxf(mx, s[i]);
    }
#pragma unroll
    for (int o = 1; o < SUBS; o <<= 1) mx = fmaxf(mx, __shfl_xor(mx, o));
    float lsum = 0.f;
#pragma unroll
    for (int i = 0; i < KPS; ++i) { const int j = sub + SUBS * i; const float p = __expf(s[i] - mx); lsum += p; if (j < NK) Pl[r * PS + j] = p; }
#pragma unroll
    for (int o = 1; o < SUBS; o <<= 1) lsum += __shfl_xor(lsum, o);
    const float inv = 1.0f / (lsum + __expf(sink - mx));
    __syncthreads();
    float acc[DPT];
#pragma unroll
    for (int d = 0; d < DPT; ++d) acc[d] = 0.f;
#pragma unroll 8
    for (int j = 0; j < NK; ++j) {
        const float p = Pl[r * PS + j]; const LAS float* vr = Vl + j * KS + sub * DPT;
#pragma unroll
        for (int d = 0; d < DPT; ++d) acc[d] += p * vr[d];
    }
    bf16* mo = (bf16*)(F.ws + WS_MIX) + (size_t)qrow * D + 256 + head * 64 + sub * DPT;
#pragma unroll
    for (int d = 0; d < DPT; d += 2) *(unsigned*)(mo + d) = pk2(acc[d] * inv, acc[d + 1] * inv);
    if (SAMPLE) {
#pragma unroll
        for (int e = tid; e < 128 * 16; e += 512) { const int w = e >> 4, sg = e & 15, j = w + 8;
            const size_t o = ((((size_t)l * SB + b) * 128 + w) * 2 + kvh) * 64 + sg * 4;
            __builtin_nontemporal_store(*(const LAS f32x4*)(Kl + j * KS + sg * 4), (f32x4*)(F.out + O_SK + o)); __builtin_nontemporal_store(*(const LAS f32x4*)(Vl + j * KS + sg * 4), (f32x4*)(F.out + O_SV + o)); }
    } else if (t0 == SEQ - 32) {
        for (int e = tid; e < 128 * 16; e += 512) { const int w = e >> 4, sg = e & 15, j = w + 31;
            const size_t o = ((((size_t)l * NB + b) * 128 + w) * 2 + kvh) * 64 + sg * 4;
            *(f32x4*)(F.out + O_PK + o) = *(const LAS f32x4*)(Kl + j * KS + sg * 4); *(f32x4*)(F.out + O_PV + o) = *(const LAS f32x4*)(Vl + j * KS + sg * 4); }
    }
    __syncthreads();
}

template <class T> __device__ __forceinline__ T* launder_ptr(T* p) {
    unsigned long long v = (unsigned long long)p; unsigned lo = (unsigned)v, hi = (unsigned)(v >> 32);
    asm volatile("" : "+v"(lo), "+v"(hi));
    lo = (unsigned)__builtin_amdgcn_readfirstlane((int)lo); hi = (unsigned)__builtin_amdgcn_readfirstlane((int)hi);
    return (T*)(GAS T*)(((unsigned long long)hi << 32) | lo);
}
#define OPAQUE_TID(Fx) do { int t_ = (Fx).tid; asm volatile("" : "+v"(t_)); (Fx).tid = t_; (Fx).lane = t_ & 63; } while (0)
typedef float f32x16 __attribute__((ext_vector_type(16)));
constexpr int LDP = 72;
constexpr int OPB = 64 * LDP * 2;
__device__ __forceinline__ void mma64(f32x16& acc, const LAS bf16* A, const LAS bf16* B, int lane) {
    const int r = lane & 31, hq = lane >> 5;
    const LAS bf16* pa = A + r * LDP + hq * 8; const LAS bf16* pb = B + r * LDP + hq * 8;
#pragma unroll
    for (int ks = 0; ks < 4; ++ks) {
        const bf16x8 a = *(const LAS bf16x8*)(pa + ks * 16), b = *(const LAS bf16x8*)(pb + ks * 16);
        acc = __builtin_amdgcn_mfma_f32_32x32x16_bf16(a, b, acc, 0, 0, 0);
    }
}
__device__ __forceinline__ int acc_row(int i, int hq) { return (i & 3) + 8 * (i >> 2) + 4 * hq; }
__device__ __forceinline__ float incl_scan64(float x, int lane) {
#pragma unroll
    for (int o = 1; o < 64; o <<= 1) { const float y = __shfl_up(x, o); if (lane >= o) x += y; }
    return x;
}
#define F32X16_ZERO (f32x16){0.f,0.f,0.f,0.f,0.f,0.f,0.f,0.f,0.f,0.f,0.f,0.f,0.f,0.f,0.f,0.f}

constexpr int SSD_F32_OFF = 129024;
__device__ __forceinline__ void ssd_chunk_scan(Frame& F, int l, int row0, LAS float* ACUM, LAS float* DTl) {
    if (F.wave < 4) {
        const int h = F.wave, t = F.lane;
        const float dt = ((const float*)(F.ws + WS_DT))[(size_t)(row0 + t) * 4 + h];
        const float A = -__expf(PIN(I_SALOG)[l * 4 + h]);
        ACUM[h * 64 + t] = incl_scan64(dt * A, t); DTl[h * 64 + t] = dt;
    }
}
template <int NCHK, int RP, class SrcCol>
__device__ __forceinline__ void ssd_raw_load(Frame& F, int row0, bool first, LAS unsigned* RAWd, SrcCol srccol) {
    const bf16* proj = PROJ(F);
    for (int e = F.tid; e < 67 * NCHK; e += 512) {
        const int rr = e / NCHK, ck = e % NCHK;
        v4u u = {0u, 0u, 0u, 0u};
        if (!(first && rr < 3)) u = *(const v4u*)(proj + (size_t)(row0 - 3 + rr) * NPROJ + srccol(ck));
        LAS unsigned* d = RAWd + rr * (RP / 2) + ck * 4;
        d[0] = u.x; d[1] = u.y; d[2] = u.z; d[3] = u.w;
    }
}
template <int NCHK, class SrcCol>
__device__ __forceinline__ void ssd_raw_issue(Frame& F, int row0, bool first, SrcCol srccol, v4u (&u)[(67 * NCHK + 511) / 512]) {
    const bf16* proj = PROJ(F);
#pragma unroll
    for (int k = 0; k < (67 * NCHK + 511) / 512; ++k) { const int e = F.tid + 512 * k, rr = e / NCHK, ck = e % NCHK;
        u[k] = (v4u){0u, 0u, 0u, 0u};
        if (e < 67 * NCHK && !(first && rr < 3)) u[k] = *(const v4u*)(proj + (size_t)(row0 - 3 + rr) * NPROJ + srccol(ck)); }
}
template <int NCHK, int RP>
__device__ __forceinline__ void ssd_raw_store(Frame& F, LAS unsigned* RAWd, const v4u (&u)[(67 * NCHK + 511) / 512]) {
#pragma unroll
    for (int k = 0; k < (67 * NCHK + 511) / 512; ++k) { const int e = F.tid + 512 * k, rr = e / NCHK, ck = e % NCHK;
        if (e < 67 * NCHK) { LAS unsigned* d = RAWd + rr * (RP / 2) + ck * 4; d[0] = u[k].x; d[1] = u[k].y; d[2] = u[k].z; d[3] = u[k].w; } }
}
__device__ __forceinline__ void hgrn_p1_load(Frame& F, int it, unsigned short (&frw)[32], unsigned short (&vrw)[32]);
__device__ __forceinline__ void ssd_mfma_p1(Frame& F, int l, int it, unsigned short (&frw)[32], unsigned short (&vrw)[32]) {
    const int b = it >> 5, c = it & 31, row0 = b * SEQ + c * 64, lane = F.lane, w = F.wave;
    constexpr int RP = 386;
    LAS bf16* RAW = (LAS bf16*)F.lds; LAS bf16* XT = (LAS bf16*)(F.lds + 52224); LAS bf16* BT = (LAS bf16*)(F.lds + 52224 + 4 * OPB);
    LAS float* ACUM = (LAS float*)(F.lds + SSD_F32_OFF); LAS float* DTl = ACUM + 256;
    const float* cw = PIN(I_SCW) + (size_t)l * 4 * 512; const float* cb = PIN(I_SCB) + (size_t)l * 512;
    {
        v4u ru[7];
        ssd_raw_issue<48>(F, row0, c == 0, [](int ck) { return ck < 32 ? 256 + ck * 8 : 512 + (ck - 32) * 8; }, ru);
        ssd_chunk_scan(F, l, row0, ACUM, DTl);
        ssd_raw_store<48, RP>(F, (LAS unsigned*)RAW, ru);
    }
    hgrn_p1_load(F, it, frw, vrw);
    __syncthreads();
    {
        const int t = lane, h = w >> 1;
        const float sc = DTl[h * 64 + t] * __expf(ACUM[h * 64 + 63] - ACUM[h * 64 + t]);
#pragma unroll
        for (int j = 0; j < 32; ++j) {
            const int ch = w * 32 + j, p = ch & 63;
            const float v = cb[ch] + cw[ch] * bf2f(RAW[t * RP + ch]) + cw[512 + ch] * bf2f(RAW[(t + 1) * RP + ch]) + cw[1024 + ch] * bf2f(RAW[(t + 2) * RP + ch]) + cw[1536 + ch] * bf2f(RAW[(t + 3) * RP + ch]);
            XT[h * (64 * LDP) + p * LDP + t] = f2bf_s(siluf_(v) * sc);
        }
#pragma unroll 16
        for (int j = 0; j < 16; ++j) {
            const int cn = w * 16 + j, g = cn >> 6, n = cn & 63, ch = 256 + cn;
            const float v = cb[ch] + cw[ch] * bf2f(RAW[t * RP + ch]) + cw[512 + ch] * bf2f(RAW[(t + 1) * RP + ch]) + cw[1024 + ch] * bf2f(RAW[(t + 2) * RP + ch]) + cw[1536 + ch] * bf2f(RAW[(t + 3) * RP + ch]);
            BT[g * (64 * LDP) + n * LDP + t] = f2bf_s(siluf_(v));
        }
    }
    __syncthreads();
    {
        const int h = w >> 1, mi = w & 1, g = h >> 1, r = lane & 31, hq = lane >> 5;
        bf16* so = (bf16*)(F.ws + WS_SSDLOC) + (size_t)((b * 4 + h) * NCH + c) * 4096;
#pragma unroll
        for (int ni = 0; ni < 2; ++ni) {
            f32x16 acc = F32X16_ZERO;
            mma64(acc, XT + h * (64 * LDP) + mi * 32 * LDP, BT + g * (64 * LDP) + ni * 32 * LDP, lane);
#pragma unroll
            for (int i = 0; i < 16; ++i) so[(mi * 32 + acc_row(i, hq)) * 64 + ni * 32 + r] = f2bf_s(acc[i]);
        }
        if (w < 4 && lane == 0) ((float*)(F.ws + WS_SMALL))[(b * 4 + w) * NCH + c] = __expf(ACUM[w * 64 + 63]);
    }
    if (c == NCH - 1) {
        const bf16* proj = PROJ(F); float* dst = F.out + O_PSSMC + ((size_t)l * NB + b) * 1536;
#pragma unroll
        for (int j = 0; j < 3; ++j) dst[j * 512 + F.tid] = bf2f(proj[(size_t)(row0 + 61 + j) * NPROJ + 256 + F.tid]);
    }
    __syncthreads();
}
struct HgPre { unsigned short frw[16], qrw[16], vrw[16]; v4u sinr[2]; };
__device__ __forceinline__ void hgrn_p2_load(Frame& F, int it, HgPre& P);
template <bool HOOK = false>
__device__ __forceinline__ void ssd_mfma_p2(Frame& F, int l, int it, HgPre* nextpre = nullptr) {
    const int b = it >> 5, c = it & 31, row0 = b * SEQ + c * 64, lane = F.lane, w = F.wave, tid = F.tid;
    constexpr int RP = 258;
    LAS bf16* Cn = (LAS bf16*)F.lds; LAS bf16* Bn = (LAS bf16*)(F.lds + 2 * OPB); LAS bf16* XT = (LAS bf16*)(F.lds + 4 * OPB);
    LAS bf16* RAW = (LAS bf16*)(F.lds + 8 * OPB); LAS bf16* Gm = RAW;
    LAS float* ACUM = (LAS float*)(F.lds + SSD_F32_OFF); LAS float* DTl = ACUM + 256; LAS float* ssq = (LAS float*)(F.lds + SSQ_LDS_OFF);
    const float* cw = PIN(I_SCW) + (size_t)l * 4 * 512; const float* cb = PIN(I_SCB) + (size_t)l * 512;
    const bf16* sin_g = (const bf16*)(F.ws + WS_SSDLOC) + (size_t)(b * 4 * NCH + c) * 4096;
    if (tid < 64) ssq[tid] = 0.f;
    const int h = w >> 1, mi = w & 1, g = h >> 1, r = lane & 31, hq = lane >> 5;
    const bf16* proj = PROJ(F);
    unsigned short zr[2][16];
#pragma unroll
    for (int pi = 0; pi < 2; ++pi)
#pragma unroll
        for (int i = 0; i < 16; ++i) zr[pi][i] = proj[(size_t)(row0 + mi * 32 + acc_row(i, hq)) * NPROJ + h * 64 + pi * 32 + r];
    v4u sinr[4];
#pragma unroll
    for (int k = 0; k < 4; ++k) { const int e = tid + 512 * k, hh = e >> 9, p = (e >> 3) & 63, n0 = (e & 7) * 8;
        sinr[k] = __builtin_nontemporal_load((const v4u*)(sin_g + (size_t)hh * NCH * 4096 + p * 64 + n0)); }
#define SSD_SIN_STORE(k) do { const int e_ = tid + 512 * (k), hh_ = e_ >> 9, p_ = (e_ >> 3) & 63, n0_ = (e_ & 7) * 8; \
        *(LAS v4u*)(F.lds + (hh_ < 2 ? (2 + hh_) * OPB : 12 * OPB + (hh_ - 2) * OPB) + (p_ * LDP + n0_) * 2) = sinr[k]; } while (0)
    ssd_chunk_scan(F, l, row0, ACUM, DTl);
    SSD_SIN_STORE(2); SSD_SIN_STORE(3);
    {
        ssd_raw_load<32, RP>(F, row0, c == 0, (LAS unsigned*)RAW, [](int ck) { return ck < 16 ? 256 + ck * 8 : (ck < 24 ? 512 + (ck - 16) * 8 : 640 + (ck - 24) * 8); });
        __syncthreads();
    }
    v4u rawr[5];
#pragma unroll
    for (int k = 0; k < 5; ++k) { const int e = tid + 512 * k, rr = e >> 5, ck = e & 31;
        rawr[k] = (v4u){0u, 0u, 0u, 0u};
        if (e < 67 * 32 && !(c == 0 && rr < 3)) rawr[k] = *(const v4u*)(proj + (size_t)(row0 - 3 + rr) * NPROJ + (ck < 16 ? 256 + 128 + ck * 8 : (ck < 24 ? 512 + 64 + (ck - 16) * 8 : 640 + 64 + (ck - 24) * 8))); }
#pragma unroll 1
    for (int gg = 0; gg < 2; ++gg) {
        if (gg == 1) {
#pragma unroll
            for (int k = 0; k < 5; ++k) { const int e = tid + 512 * k, rr = e >> 5, ck = e & 31;
                if (e < 67 * 32) { LAS unsigned* d = (LAS unsigned*)RAW + rr * (RP / 2) + ck * 4; d[0] = rawr[k].x; d[1] = rawr[k].y; d[2] = rawr[k].z; d[3] = rawr[k].w; } }
            __syncthreads();
        }
        {
            const int t = lane;
#pragma unroll 16
            for (int j = 0; j < 16; ++j) {
                const int cr = w * 16 + j, ch = gg * 128 + cr, hx = ch >> 6, p = ch & 63;
                const float v = cb[ch] + cw[ch] * bf2f(RAW[t * RP + cr]) + cw[512 + ch] * bf2f(RAW[(t + 1) * RP + cr]) + cw[1024 + ch] * bf2f(RAW[(t + 2) * RP + cr]) + cw[1536 + ch] * bf2f(RAW[(t + 3) * RP + cr]);
                XT[hx * (64 * LDP) + p * LDP + t] = f2bf_s(siluf_(v));
            }
        }
        {
            const int n = lane, chB = 256 + gg * 64 + n, chC = 384 + gg * 64 + n;
            const float b0 = cw[chB], b1 = cw[512 + chB], b2 = cw[1024 + chB], b3 = cw[1536 + chB], bb = cb[chB];
            const float c0 = cw[chC], c1 = cw[512 + chC], c2 = cw[1024 + chC], c3 = cw[1536 + chC], cc = cb[chC];
#pragma unroll 16
            for (int j = 0; j < 8; ++j) {
                const int t = w * 8 + j;
                const float vb = bb + b0 * bf2f(RAW[t * RP + 128 + n]) + b1 * bf2f(RAW[(t + 1) * RP + 128 + n]) + b2 * bf2f(RAW[(t + 2) * RP + 128 + n]) + b3 * bf2f(RAW[(t + 3) * RP + 128 + n]);
                const float vc = cc + c0 * bf2f(RAW[t * RP + 192 + n]) + c1 * bf2f(RAW[(t + 1) * RP + 192 + n]) + c2 * bf2f(RAW[(t + 2) * RP + 192 + n]) + c3 * bf2f(RAW[(t + 3) * RP + 192 + n]);
                Bn[gg * (64 * LDP) + t * LDP + n] = f2bf_s(siluf_(vb)); Cn[gg * (64 * LDP) + t * LDP + n] = f2bf_s(siluf_(vc));
            }
        }
        __syncthreads();
    }
    {
#pragma unroll
        for (int ni = 0; ni < 2; ++ni) {
            f32x16 acc = F32X16_ZERO;
            if (ni <= mi) mma64(acc, Cn + g * (64 * LDP) + mi * 32 * LDP, Bn + g * (64 * LDP) + ni * 32 * LDP, lane);
            const int s = ni * 32 + r; const float acs = ACUM[h * 64 + s], dts = DTl[h * 64 + s];
#pragma unroll
            for (int i = 0; i < 16; ++i) {
                const int t = mi * 32 + acc_row(i, hq);
                const float v = (ni <= mi && s <= t) ? acc[i] * __expf(ACUM[h * 64 + t] - acs) * dts : 0.f;
                Gm[h * (64 * LDP) + t * LDP + s] = f2bf_s(v);
            }
        }
    }
    __syncthreads();
    SSD_SIN_STORE(0); SSD_SIN_STORE(1);
#undef SSD_SIN_STORE
    __syncthreads();
    float yg[2][16];
    {
        const LAS bf16* Sin = (const LAS bf16*)(F.lds + (h < 2 ? (2 + h) * OPB : 12 * OPB + (h - 2) * OPB));
        const float Dh = PIN(I_SD)[l * 4 + h];
        float eac[16];
#pragma unroll
        for (int i = 0; i < 16; ++i) eac[i] = __expf(ACUM[h * 64 + mi * 32 + acc_row(i, hq)]);
#pragma unroll
        for (int pi = 0; pi < 2; ++pi) {
            f32x16 ay = F32X16_ZERO, ao = F32X16_ZERO;
            mma64(ay, Gm + h * (64 * LDP) + mi * 32 * LDP, XT + h * (64 * LDP) + pi * 32 * LDP, lane);
            mma64(ao, Cn + g * (64 * LDP) + mi * 32 * LDP, Sin + pi * 32 * LDP, lane);
            const int p = pi * 32 + r;
#pragma unroll
            for (int i = 0; i < 16; ++i) {
                const int t = mi * 32 + acc_row(i, hq);
                const float xs = bf2f(XT[h * (64 * LDP) + p * LDP + t]);
                const float z = bf2f(zr[pi][i]);
                yg[pi][i] = (ay[i] + ao[i] * eac[i] + Dh * xs) * siluf_(z);
            }
        }
#pragma unroll
        for (int i = 0; i < 16; ++i) {
            float q = yg[0][i] * yg[0][i] + yg[1][i] * yg[1][i];
            q = half32_sum_hi(q);
            if (r == 31) __hip_atomic_fetch_add(ssq + mi * 32 + acc_row(i, hq), q, __ATOMIC_RELAXED, __HIP_MEMORY_SCOPE_WORKGROUP);
        }
    }
    if (HOOK) hgrn_p2_load(F, it, *nextpre);
    __syncthreads();
    {
        bf16* mix = (bf16*)(F.ws + WS_MIX);
#pragma unroll
        for (int pi = 0; pi < 2; ++pi) {
            const int ch = h * 64 + pi * 32 + r; const float nw = PIN(I_SNW)[l * 256 + ch];
#pragma unroll
            for (int i = 0; i < 16; ++i) {
                const int t = mi * 32 + acc_row(i, hq);
                const float rs = rsqf_(ssq[t] * (1.0f / 256.0f) + EPS);
                mix[(size_t)(row0 + t) * D + ch] = f2bf_s(yg[pi][i] * rs * nw);
            }
        }
    }
    __syncthreads();
}

constexpr int HG_TOT_OFF = 12 * OPB, HG_SSQ_OFF = HG_TOT_OFF + 2048;
template <bool PASS2>
__device__ __forceinline__ void hgrn_elem(Frame& F, int l, int row0, int hp) {
    const int w = F.wave, lane = F.lane, hl = w >> 2, seg = w & 3, h = hp * 2 + hl, ch = h * 64 + lane;
    const bf16* proj = PROJ(F);
    LAS float* TOT = (LAS float*)(F.lds + HG_TOT_OFF);
    const float lbk = (l == 0) ? 0.f : sigmoidf_(PIN(I_HLB)[256 + ch] - PIN(I_HLB)[ch]);
    float fr[16], bc[16]; unsigned short qraw[16];
#pragma unroll
    for (int i = 0; i < 16; ++i) { fr[i] = bf2f(proj[(size_t)(row0 + seg * 16 + i) * NPROJ + 1536 + ch]); qraw[i] = PASS2 ? proj[(size_t)(row0 + seg * 16 + i) * NPROJ + 1280 + ch] : (unsigned short)0; }
    float run = 0.f;
#pragma unroll
    for (int i = 0; i < 16; ++i) { const float f = lbk + (1.0f - lbk) * sigmoidf_(fr[i]); run += __logf(f); bc[i] = run; }
    TOT[(hl * 4 + seg) * 64 + lane] = run;
    __syncthreads();
    const float t0 = TOT[(hl * 4 + 0) * 64 + lane], t1 = TOT[(hl * 4 + 1) * 64 + lane], t2 = TOT[(hl * 4 + 2) * 64 + lane], t3 = TOT[(hl * 4 + 3) * 64 + lane];
    const float off = seg == 0 ? 0.f : seg == 1 ? t0 : seg == 2 ? t0 + t1 : t0 + t1 + t2;
    const float ref = t0 + t1, tot = (t0 + t1) + (t2 + t3);
    if (PASS2) {
        LAS bf16* QT = (LAS bf16*)(F.lds + (hl * 6 + 0) * OPB); LAS bf16* KT = (LAS bf16*)(F.lds + (hl * 6 + 1) * OPB); LAS bf16* QP = (LAS bf16*)(F.lds + (hl * 6 + 2) * OPB);
#pragma unroll
        for (int i = 0; i < 16; ++i) {
            const int t = seg * 16 + i; const float b_ = bc[i] + off;
            const float q = bf2f(qraw[i]);
            const float kk = (1.0f - lbk) / (1.0f + __expf(fr[i]));
            QT[t * LDP + lane] = f2bf_s(q * __expf(b_ - ref)); KT[t * LDP + lane] = f2bf_s(kk * __expf(ref - b_)); QP[t * LDP + lane] = f2bf_s(q * __expf(b_));
        }
    } else {
        LAS bf16* KPT = (LAS bf16*)(F.lds + (hl * 2 + 1) * OPB);
#pragma unroll
        for (int i = 0; i < 16; ++i) {
            const int t = seg * 16 + i; const float b_ = bc[i] + off;
            const float kk = (1.0f - lbk) / (1.0f + __expf(fr[i]));
            KPT[lane * LDP + t] = f2bf_s(kk * __expf(tot - b_));
        }
    }
}
__device__ __forceinline__ void hgrn_vt(Frame& F, int row0, int hp, int tile_stride, int tile_off) {
    const int w = F.wave, lane = F.lane, hl = w >> 2, seg = w & 3, h = hp * 2 + hl, ch = h * 64 + lane;
    const bf16* proj = PROJ(F);
    LAS bf16* VT = (LAS bf16*)(F.lds + (hl * tile_stride + tile_off) * OPB);
#pragma unroll
    for (int i = 0; i < 16; ++i) { const int t = seg * 16 + i; VT[lane * LDP + t] = proj[(size_t)(row0 + t) * NPROJ + 1792 + ch]; }
}
__device__ __forceinline__ void hgrn_p1_load(Frame& F, int it, unsigned short (&frw)[32], unsigned short (&vrw)[32]) {
    const int b = it >> 5, c = it & 31, row0 = b * SEQ + c * 64, h = F.wave >> 1, th = F.wave & 1, ch = h * 64 + F.lane;
    const bf16* proj = PROJ(F);
#pragma unroll
    for (int i = 0; i < 32; ++i) { const bf16* p = proj + (size_t)(row0 + th * 32 + i) * NPROJ + ch; frw[i] = p[1536]; vrw[i] = p[1792]; }
}
__device__ __forceinline__ void hgrn_mfma_p1(Frame& F, int l, int it, const unsigned short (&frw)[32], const unsigned short (&vrw)[32]) {
    const int b = it >> 5, c = it & 31, row0 = b * SEQ + c * 64, lane = F.lane, w = F.wave;
    const int h = w >> 1, th = w & 1, ch = h * 64 + lane;
    const bf16* proj = PROJ(F);
    LAS float* TOT = (LAS float*)(F.lds + HG_TOT_OFF);
    LAS bf16* VT = (LAS bf16*)(F.lds + (h * 2 + 0) * OPB); LAS bf16* KPT = (LAS bf16*)(F.lds + (h * 2 + 1) * OPB);
    const float lbk = (l == 0) ? 0.f : sigmoidf_(PIN(I_HLB)[256 + ch] - PIN(I_HLB)[ch]);
    float fr[32]; unsigned short vr[32];
#pragma unroll
    for (int i = 0; i < 32; ++i) { fr[i] = bf2f(frw[i]); vr[i] = vrw[i]; }
    float bc[32]; float run = 0.f;
#pragma unroll
    for (int i = 0; i < 32; ++i) { const float sg = sigmoidf_(fr[i]), f = lbk + (1.0f - lbk) * sg; run += __logf(f); bc[i] = run; fr[i] = 1.0f - sg; }
    TOT[(h * 2 + th) * 64 + lane] = run;
#pragma unroll
    for (int i = 0; i < 32; ++i) VT[lane * LDP + th * 32 + i] = vr[i];
    __syncthreads();
    const float t0 = TOT[(h * 2 + 0) * 64 + lane], t1 = TOT[(h * 2 + 1) * 64 + lane], tot = t0 + t1, off = th ? t0 : 0.f;
#pragma unroll
    for (int i = 0; i < 32; ++i) {
        const float kk = (1.0f - lbk) * fr[i];
        KPT[lane * LDP + th * 32 + i] = f2bf_s(kk * __expf(tot - (bc[i] + off)));
    }
    __syncthreads();
    {
        const int mi = th, r = lane & 31, hq = lane >> 5, sidx = (b * 4 + h) * NCH + c;
        bf16* so = (bf16*)(F.ws + WS_HGLOC) + (size_t)sidx * 4096;
#pragma unroll
        for (int ni = 0; ni < 2; ++ni) {
            f32x16 acc = F32X16_ZERO;
            mma64(acc, VT + mi * 32 * LDP, KPT + ni * 32 * LDP, lane);
#pragma unroll
            for (int i = 0; i < 16; ++i) so[(mi * 32 + acc_row(i, hq)) * 64 + ni * 32 + r] = f2bf_s(acc[i]);
        }
        if (th == 0) ((float*)(F.ws + WS_SMALL))[1024 + (size_t)sidx * 64 + lane] = __expf(tot);
    }
    __syncthreads();
}
#define HG_LOAD_INTO(P_, hp_) do { const int ch_ = ((hp_) * 2 + hl) * 64 + lane; \
        _Pragma("unroll") for (int i = 0; i < 16; ++i) { const bf16* p_ = proj + (size_t)(row0 + seg * 16 + i) * NPROJ + ch_; (P_).frw[i] = p_[1536]; (P_).qrw[i] = p_[1280]; (P_).vrw[i] = p_[1792]; } \
        _Pragma("unroll") for (int k = 0; k < 2; ++k) { const int e_ = tid + 512 * k, hl_ = e_ >> 9, v_ = (e_ >> 3) & 63, k0_ = (e_ & 7) * 8; \
            (P_).sinr[k] = __builtin_nontemporal_load((const v4u*)((const bf16*)(F.ws + WS_HGLOC) + (size_t)((b * 4 + (hp_) * 2 + hl_) * NCH + c) * 4096 + v_ * 64 + k0_)); } } while (0)
__device__ __forceinline__ void hgrn_p2_load(Frame& F, int it, HgPre& P) {
    const int b = it >> 5, c = it & 31, row0 = b * SEQ + c * 64, lane = F.lane, w = F.wave, tid = F.tid, hl = w >> 2, seg = w & 3;
    const bf16* proj = PROJ(F);
    HG_LOAD_INTO(P, 0);
}
struct LruP2 { f32x4 hin; v4u cv[8]; v2u gv[8]; };
__device__ __forceinline__ void lru_p2_load(Frame& F, int it, LruP2& P) {
    const int b = it >> 5, c = it & 31, row0 = b * SEQ + c * 64, lane = F.lane, w = F.wave;
    const bf16* proj = PROJ(F); const unsigned* cache = (const unsigned*)(F.out + O_Y);
    const float* lruH = (const float*)(F.ws + WS_SMALL) + 1024 + 65536;
    P.hin = *(const f32x4*)(lruH + (size_t)(b * NCH + c) * 256 + lane * 4);
#pragma unroll
    for (int j = 0; j < 8; ++j) { const int t = w * 8 + j;
        P.cv[j] = __builtin_nontemporal_load((const v4u*)(cache + (size_t)(row0 + t) * 256 + lane * 4)); P.gv[j] = *(const v2u*)(proj + (size_t)(row0 + t) * NPROJ + 2560 + lane * 4); }
}
__device__ __forceinline__ void lru_p2_finish(Frame& F, int it, const LruP2& P) {
    const int b = it >> 5, c = it & 31, row0 = b * SEQ + c * 64, lane = F.lane, w = F.wave;
    bf16* mix = (bf16*)(F.ws + WS_MIX); const f32x4 hin = P.hin;
#pragma unroll
    for (int j = 0; j < 8; ++j) { const int t = w * 8 + j; const v4u cv = P.cv[j]; const v2u gv = P.gv[j];
        const float h0 = bflo(cv.x) + bfhi(cv.x) * hin.x, h1 = bflo(cv.y) + bfhi(cv.y) * hin.y, h2 = bflo(cv.z) + bfhi(cv.z) * hin.z, h3 = bflo(cv.w) + bfhi(cv.w) * hin.w;
        v2u o; o.x = pk2(h0 * geluf_(bflo(gv.x)), h1 * geluf_(bfhi(gv.x))); o.y = pk2(h2 * geluf_(bflo(gv.y)), h3 * geluf_(bfhi(gv.y)));
        *(v2u*)(mix + (size_t)(row0 + t) * D + 768 + lane * 4) = o; }
}
template <bool PRELOADED = false>
__device__ __forceinline__ void hgrn_mfma_p2(Frame& F, int l, int it, HgPre* pre = nullptr, LruP2* lp = nullptr) {
    const int b = it >> 5, c = it & 31, row0 = b * SEQ + c * 64, lane = F.lane, w = F.wave, tid = F.tid;
    const int hl = w >> 2, seg = w & 3, mi = (w >> 1) & 1, ni = w & 1, r = lane & 31, hq = lane >> 5;
    const bf16* proj = PROJ(F); bf16* mix = (bf16*)(F.ws + WS_MIX);
    LAS float* ssq = (LAS float*)(F.lds + HG_SSQ_OFF); LAS float* TOT = (LAS float*)(F.lds + HG_TOT_OFF);
    const LAS bf16* QT = (const LAS bf16*)(F.lds + (hl * 6 + 0) * OPB); const LAS bf16* KT = (const LAS bf16*)(F.lds + (hl * 6 + 1) * OPB);
    const LAS bf16* QP = (const LAS bf16*)(F.lds + (hl * 6 + 2) * OPB); LAS bf16* VT = (LAS bf16*)(F.lds + (hl * 6 + 3) * OPB);
    const LAS bf16* SIN = (const LAS bf16*)(F.lds + (hl * 6 + 4) * OPB); LAS bf16* AM = (LAS bf16*)(F.lds + (hl * 6 + 5) * OPB);
    HgPre R;
    if (PRELOADED) R = *pre; else HG_LOAD_INTO(R, 0);
#pragma unroll
    for (int hp = 0; hp < 2; ++hp) {
        const int h = hp * 2 + hl, ch = h * 64 + lane;
        if (tid < 128) ssq[tid] = 0.f;
        const float lbk = (l == 0) ? 0.f : sigmoidf_(PIN(I_HLB)[256 + ch] - PIN(I_HLB)[ch]);
        float fr[16], bc[16], qv[16];
        {
            float run = 0.f;
#pragma unroll
            for (int i = 0; i < 16; ++i) { qv[i] = bf2f(R.qrw[i]); const float sg = sigmoidf_(bf2f(R.frw[i])), f = lbk + (1.0f - lbk) * sg; fr[i] = 1.0f - sg; run += __logf(f); bc[i] = run; VT[lane * LDP + seg * 16 + i] = R.vrw[i]; }
            TOT[(hl * 4 + seg) * 64 + lane] = run;
#pragma unroll
            for (int k = 0; k < 2; ++k) { const int e_ = tid + 512 * k, hl_ = e_ >> 9, v_ = (e_ >> 3) & 63, k0_ = (e_ & 7) * 8;
                *(LAS v4u*)(F.lds + (hl_ * 6 + 4) * OPB + (v_ * LDP + k0_) * 2) = R.sinr[k]; }
        }
        if (hp == 0) HG_LOAD_INTO(R, 1);
        else if (lp) lru_p2_load(F, it, *lp);
        __syncthreads();
        {
            const float t0 = TOT[(hl * 4 + 0) * 64 + lane], t1 = TOT[(hl * 4 + 1) * 64 + lane], t2 = TOT[(hl * 4 + 2) * 64 + lane];
            const float off = seg == 0 ? 0.f : seg == 1 ? t0 : seg == 2 ? t0 + t1 : t0 + t1 + t2, ref = t0 + t1, eref = __expf(ref);
            LAS bf16* QTw = (LAS bf16*)QT; LAS bf16* KTw = (LAS bf16*)KT; LAS bf16* QPw = (LAS bf16*)QP;
#pragma unroll
            for (int i = 0; i < 16; ++i) {
                const int t = seg * 16 + i; const float b_ = bc[i] + off, kk = (1.0f - lbk) * fr[i], e1 = __expf(b_ - ref), qe = qv[i] * e1;
                QTw[t * LDP + lane] = f2bf_s(qe); KTw[t * LDP + lane] = f2bf_s(kk * rcpf_(e1)); QPw[t * LDP + lane] = f2bf_s(qe * eref);
            }
        }
        __syncthreads();
        unsigned short graw[16];
#pragma unroll
        for (int i = 0; i < 16; ++i) graw[i] = proj[(size_t)(row0 + mi * 32 + acc_row(i, hq)) * NPROJ + 2048 + h * 64 + ni * 32 + r];
        {
            f32x16 acc = F32X16_ZERO;
            if (ni <= mi) mma64(acc, QT + mi * 32 * LDP, KT + ni * 32 * LDP, lane);
            const int sidx = ni * 32 + r;
#pragma unroll
            for (int i = 0; i < 16; ++i) { const int t = mi * 32 + acc_row(i, hq); AM[t * LDP + sidx] = f2bf_s((ni <= mi && sidx <= t) ? acc[i] : 0.f); }
        }
        __syncthreads();
        f32x16 o = F32X16_ZERO;
        mma64(o, AM + mi * 32 * LDP, VT + ni * 32 * LDP, lane);
        mma64(o, QP + mi * 32 * LDP, SIN + ni * 32 * LDP, lane);
#pragma unroll
        for (int i = 0; i < 16; ++i) {
            float q = o[i] * o[i];
            q = half32_sum_hi(q);
            if (r == 31) __hip_atomic_fetch_add(ssq + hl * 64 + mi * 32 + acc_row(i, hq), q, __ATOMIC_RELAXED, __HIP_MEMORY_SCOPE_WORKGROUP);
        }
        __syncthreads();
        {
            const int cho = h * 64 + ni * 32 + r; const float nw = PIN(I_HNW)[l * 256 + cho];
#pragma unroll
            for (int i = 0; i < 16; ++i) {
                const int t = mi * 32 + acc_row(i, hq);
                const float rs = rsqf_(ssq[hl * 64 + t] * (1.0f / 64.0f) + EPS);
                mix[(size_t)(row0 + t) * D + 512 + cho] = f2bf_s(o[i] * rs * nw * sigmoidf_(bf2f(graw[i])));
            }
        }
        __syncthreads();
    }
}

constexpr int LRU_RP = 258, LRU_XP = 264, LRU_XC_OFF = 36864;
__device__ __forceinline__ void lru_raw_load(Frame& F, int it, v4u (&rawr)[5]) {
    const int b = it >> 5, c = it & 31, row0 = b * SEQ + c * 64; const bf16* proj = PROJ(F);
#pragma unroll
    for (int k = 0; k < 5; ++k) { const int e = F.tid + 512 * k, rr = e >> 5, ck = e & 31;
        rawr[k] = (v4u){0u, 0u, 0u, 0u};
        if (e < 67 * 32 && !(c == 0 && rr < 3)) rawr[k] = *(const v4u*)(proj + (size_t)(row0 - 3 + rr) * NPROJ + 2304 + ck * 8); }
}
template <bool PASS2, bool PRELOADED = false>
__device__ __forceinline__ void lru_mfma(Frame& F, int l, int it, const v4u (*rawr)[5] = nullptr) {
    const int b = it >> 5, c = it & 31, row0 = b * SEQ + c * 64, lane = F.lane, w = F.wave, tid = F.tid;
    LAS bf16* RAW = (LAS bf16*)F.lds; LAS bf16* Xc = (LAS bf16*)(F.lds + LRU_XC_OFF);
    const bf16* proj = PROJ(F);
    if (PRELOADED) {
#pragma unroll
        for (int k = 0; k < 5; ++k) { const int e = tid + 512 * k, rr = e >> 5, ck = e & 31;
            if (e < 67 * 32) { LAS unsigned* d = (LAS unsigned*)RAW + rr * (LRU_RP / 2) + ck * 4; d[0] = (*rawr)[k].x; d[1] = (*rawr)[k].y; d[2] = (*rawr)[k].z; d[3] = (*rawr)[k].w; } }
    } else ssd_raw_load<32, LRU_RP>(F, row0, c == 0, (LAS unsigned*)RAW, [](int ck) { return 2304 + ck * 8; });
    __syncthreads();
    {
        const float* cw = PIN(I_LCW) + (size_t)l * 4 * 256; const float* cb = PIN(I_LCB) + (size_t)l * 256;
#pragma unroll
        for (int q = 0; q < 4; ++q) {
            const int ch = q * 64 + lane; const float w0 = cw[ch], w1 = cw[256 + ch], w2 = cw[512 + ch], w3 = cw[768 + ch], bb = cb[ch];
#pragma unroll 16
            for (int j = 0; j < 8; ++j) { const int t = w * 8 + j;
                Xc[t * LRU_XP + ch] = f2bf_s(bb + w0 * bf2f(RAW[t * LRU_RP + ch]) + w1 * bf2f(RAW[(t + 1) * LRU_RP + ch]) + w2 * bf2f(RAW[(t + 2) * LRU_RP + ch]) + w3 * bf2f(RAW[(t + 3) * LRU_RP + ch])); }
        }
    }
    __syncthreads();
    const int blk = w >> 1, ni = w & 1, r = lane & 31, hq = lane >> 5, ch = blk * 64 + ni * 32 + r;
    unsigned short graw[2][16];
    if (PASS2) {
#pragma unroll
        for (int mi = 0; mi < 2; ++mi)
#pragma unroll
            for (int i = 0; i < 16; ++i) graw[mi][i] = proj[(size_t)(row0 + mi * 32 + acc_row(i, hq)) * NPROJ + 2560 + ch];
    }
    f32x16 ar[2] = {F32X16_ZERO, F32X16_ZERO}, ai[2] = {F32X16_ZERO, F32X16_ZERO};
    {
        const bf16* wt = (const bf16*)(F.ws + WS_LWT) + (size_t)(l * 2 * 4 + blk) * 4096 + (ni * 32 + r) * 64 + hq * 8;
#pragma unroll
        for (int ks = 0; ks < 4; ++ks) {
            const bf16x8 br = *(const bf16x8*)(wt + ks * 16), bi = *(const bf16x8*)(wt + 4 * 4096 + ks * 16);
#pragma unroll
            for (int mi = 0; mi < 2; ++mi) {
                const bf16x8 a = *(const LAS bf16x8*)(Xc + (mi * 32 + r) * LRU_XP + blk * 64 + ks * 16 + hq * 8);
                ar[mi] = __builtin_amdgcn_mfma_f32_32x32x16_bf16(a, br, ar[mi], 0, 0, 0);
                ai[mi] = __builtin_amdgcn_mfma_f32_32x32x16_bf16(a, bi, ai[mi], 0, 0, 0);
            }
        }
    }
    const float ba = PIN(I_LBA)[l * 256 + ch], bx = PIN(I_LBX)[l * 256 + ch], sp = softplusf_(-PIN(I_LLAM)[l * 256 + ch]);
#pragma unroll
    for (int mi = 0; mi < 2; ++mi)
#pragma unroll
        for (int i = 0; i < 16; ++i) {
            const int t = mi * 32 + acc_row(i, hq);
            const float xc = bf2f(Xc[t * LRU_XP + ch]);
            const float log_a = -8.0f * sigmoidf_(ar[mi][i] + ba) * sp, ig = sigmoidf_(ai[mi][i] + bx);
            const float a_ = __expf(log_a), z2 = 2.0f * log_a;
            const float om = z2 > -0.25f ? -z2 * (1.0f + z2 * (0.5f + z2 * (0.16666667f + z2 * (0.041666668f + z2 * 0.008333334f)))) : 1.0f - a_ * a_;
            ar[mi][i] = a_; ai[mi][i] = __builtin_amdgcn_sqrtf(om) * (ig * xc);
        }
    float Ao[8], Uo[8], Ap[8], Up[8];
#pragma unroll
    for (int k = 0; k < 8; ++k) { const int mi = k >> 2, i0 = (k & 3) * 4;
        float A = ar[mi][i0], U = ai[mi][i0];
#pragma unroll
        for (int j = 1; j < 4; ++j) { U = U * ar[mi][i0 + j] + ai[mi][i0 + j]; A *= ar[mi][i0 + j]; }
        Ao[k] = A; Uo[k] = U; Ap[k] = __shfl_xor(A, 32); Up[k] = __shfl_xor(U, 32); }
    float* lruH = (float*)(F.ws + WS_SMALL) + 1024 + 65536; float* lruA = lruH + 65536;
    float h = PASS2 ? lruH[(size_t)(b * NCH + c) * 256 + ch] : 0.f, hs[8], as[8], atot = 1.0f;
#pragma unroll
    for (int k = 0; k < 8; ++k) {
        const float A1 = hq ? Ap[k] : Ao[k], U1 = hq ? Up[k] : Uo[k], A2 = hq ? Ao[k] : Ap[k], U2 = hq ? Uo[k] : Up[k];
        const float h1 = A1 * h + U1;
        hs[k] = hq ? h1 : h; as[k] = hq ? atot * A1 : atot;
        h = A2 * h1 + U2; atot *= A1 * A2;
    }
    if (!PASS2) {
        if (hq == 0) { lruH[(size_t)(b * NCH + c) * 256 + ch] = h; lruA[(size_t)(b * NCH + c) * 256 + ch] = atot; }
        {
            unsigned* cache = (unsigned*)(F.out + O_Y);
#pragma unroll
            for (int k = 0; k < 8; ++k) { const int mi = k >> 2, i0 = (k & 3) * 4; float hc = hs[k], ac = as[k];
#pragma unroll
                for (int j = 0; j < 4; ++j) {
                    hc = ar[mi][i0 + j] * hc + ai[mi][i0 + j]; ac *= ar[mi][i0 + j];
                    __builtin_nontemporal_store(pk2(hc, ac), cache + (size_t)(row0 + mi * 32 + acc_row(i0 + j, hq)) * 256 + ch);
                }
            }
        }
        if (c == NCH - 1 && tid < 256) {
#pragma unroll
            for (int j = 0; j < 3; ++j) F.out[O_PLRUC + ((size_t)l * NB + b) * 768 + j * 256 + tid] = bf2f(proj[(size_t)(row0 + 61 + j) * NPROJ + 2304 + tid]);
        }
    } else {
        bf16* mix = (bf16*)(F.ws + WS_MIX);
#pragma unroll
        for (int k = 0; k < 8; ++k) { const int mi = k >> 2, i0 = (k & 3) * 4; float hc = hs[k];
#pragma unroll
            for (int j = 0; j < 4; ++j) {
                hc = ar[mi][i0 + j] * hc + ai[mi][i0 + j];
                const int t = mi * 32 + acc_row(i0 + j, hq);
                const float gv = bf2f(graw[mi][i0 + j]);
                mix[(size_t)(row0 + t) * D + 768 + ch] = f2bf_s(hc * geluf_(gv));
            }
        }
    }
    __syncthreads();
}

constexpr int SW_KOFF = 0, SW_VP = 200, SW_VR = 96  , SW_VOFF = 192 * LDP * 2, SW_POFF = SW_VOFF + 192 * SW_VR * 2, SW_BOFF = SW_POFF + 128 * SW_VP * 2, SW_MOFF = SW_BOFF + 1024, SW_SOFF = SW_MOFF + 1024;
__device__ __forceinline__ void swa_mfma(Frame& F, int l, int it) {
    const int b = it >> 6, kvh = (it >> 5) & 1, t0 = (it & 31) * 64, seqrow0 = b * SEQ, lane = F.lane, w = F.wave, tid = F.tid;
    const int rt = w >> 1, kh = w & 1, qh = rt >> 1, qhalf = rt & 1, head = kvh * 2 + qh, r = lane & 31, hq = lane >> 5;
    const bf16* proj = PROJ(F);
    LAS bf16* Kl = (LAS bf16*)(F.lds + SW_KOFF); LAS bf16* VT = (LAS bf16*)(F.lds + SW_VOFF); LAS bf16* Pl = (LAS bf16*)(F.lds + SW_POFF);
    LAS float* Bl = (LAS float*)(F.lds + SW_BOFF); LAS float* Ms = (LAS float*)(F.lds + SW_MOFF); LAS float* Ss = (LAS float*)(F.lds + SW_SOFF);
    bf16x8 qf[4];
    { const bf16* qp = proj + (size_t)(seqrow0 + t0 + qhalf * 32 + r) * NPROJ + 768 + head * 64 + hq * 8;
#pragma unroll
      for (int ks = 0; ks < 4; ++ks) qf[ks] = *(const bf16x8*)(qp + ks * 16); }
    if (tid < 256) { const int q2 = tid >> 7, df = tid & 127; Bl[tid] = PIN(I_RELB)[t5_bucket(df) * 4 + kvh * 2 + q2]; }
#pragma unroll
    for (int e = tid; e < 192 * 8; e += 512) {
        const int j = e >> 3, sg = e & 7, kp = t0 - 127 + j;
        v4u ku = {0u, 0u, 0u, 0u}, vu = ku;
        if (kp >= 0 && j < 191) { const bf16* p = proj + (size_t)(seqrow0 + kp) * NPROJ + kvh * 64 + sg * 8; ku = *(const v4u*)(p + 1024); vu = *(const v4u*)(p + 1152); }
        *(LAS v4u*)(Kl + j * LDP + sg * 8) = ku;
        *(LAS v4u*)(VT + j * SW_VR + sg * 8) = vu;
    }
    __syncthreads();
    f32x16 sc[3];
    const int tq = qhalf * 32 + r;
    const float sink = PIN(I_SINK)[l * 4 + head];
    float mx = -INFINITY;
#pragma unroll
    for (int kt = 0; kt < 3; ++kt) {
        f32x16 acc = F32X16_ZERO;
        const LAS bf16* ka = Kl + ((kh * 3 + kt) * 32 + r) * LDP + hq * 8;
#pragma unroll
        for (int ks = 0; ks < 4; ++ks) acc = __builtin_amdgcn_mfma_f32_32x32x16_bf16(*(const LAS bf16x8*)(ka + ks * 16), qf[ks], acc, 0, 0, 0);
#pragma unroll
        for (int i = 0; i < 16; ++i) {
            const int j = (kh * 3 + kt) * 32 + acc_row(i, hq), df = tq + 127 - j, kp = t0 - 127 + j;
            const bool valid = (df >= 0) && (df < 128) && (kp >= 0);
            const float s = valid ? acc[i] * 0.125f + Bl[qh * 128 + (df & 127)] : -INFINITY;
            acc[i] = s; mx = fmaxf(mx, s);
        }
        sc[kt] = acc;
    }
    mx = fmaxf(mx, __shfl_xor(mx, 32));
    if (hq == 0) Ms[(rt * 2 + kh) * 32 + r] = mx;
    __syncthreads();
    mx = fmaxf(fmaxf(mx, Ms[(rt * 2 + (kh ^ 1)) * 32 + r]), sink);
    float sum = 0.f;
#pragma unroll
    for (int kt = 0; kt < 3; ++kt)
#pragma unroll
        for (int g4 = 0; g4 < 4; ++g4) {
            const float p0 = __expf(sc[kt][4 * g4] - mx), p1 = __expf(sc[kt][4 * g4 + 1] - mx), p2 = __expf(sc[kt][4 * g4 + 2] - mx), p3 = __expf(sc[kt][4 * g4 + 3] - mx);
            sum += (p0 + p1) + (p2 + p3);
            v2u pk; pk.x = pk2(p0, p1); pk.y = pk2(p2, p3);
            *(LAS v2u*)(Pl + (rt * 32 + r) * SW_VP + (kh * 3 + kt) * 32 + 8 * g4 + 4 * hq) = pk;
        }
    sum += __shfl_xor(sum, 32);
    if (hq == 0) Ss[(rt * 2 + kh) * 32 + r] = sum;
    __syncthreads();
    {
        f32x16 o = F32X16_ZERO;
        const LAS bf16* pa = Pl + (rt * 32 + r) * SW_VP + hq * 8;
        const unsigned vaddr = (unsigned)(unsigned long long)(F.lds + SW_VOFF) + (unsigned)(((8 * hq + ((lane & 15) >> 2)) * SW_VR + 32 * kh + 16 * ((lane >> 4) & 1) + 4 * (lane & 3)) * 2);
        v2u tv[24];
        asm volatile("ds_read_b64_tr_b16 %0, %8 offset:0\n\t" "ds_read_b64_tr_b16 %1, %8 offset:768\n\t" "ds_read_b64_tr_b16 %2, %8 offset:3072\n\t" "ds_read_b64_tr_b16 %3, %8 offset:3840\n\t" "ds_read_b64_tr_b16 %4, %8 offset:6144\n\t" "ds_read_b64_tr_b16 %5, %8 offset:6912\n\t" "ds_read_b64_tr_b16 %6, %8 offset:9216\n\t" "ds_read_b64_tr_b16 %7, %8 offset:9984\n\t" "s_waitcnt lgkmcnt(0)" : "=&v"(tv[0]), "=&v"(tv[1]), "=&v"(tv[2]), "=&v"(tv[3]), "=&v"(tv[4]), "=&v"(tv[5]), "=&v"(tv[6]), "=&v"(tv[7]) : "v"(vaddr) : "memory");
        asm volatile("ds_read_b64_tr_b16 %0, %8 offset:12288\n\t" "ds_read_b64_tr_b16 %1, %8 offset:13056\n\t" "ds_read_b64_tr_b16 %2, %8 offset:15360\n\t" "ds_read_b64_tr_b16 %3, %8 offset:16128\n\t" "ds_read_b64_tr_b16 %4, %8 offset:18432\n\t" "ds_read_b64_tr_b16 %5, %8 offset:19200\n\t" "ds_read_b64_tr_b16 %6, %8 offset:21504\n\t" "ds_read_b64_tr_b16 %7, %8 offset:22272\n\t" "s_waitcnt lgkmcnt(0)" : "=&v"(tv[8]), "=&v"(tv[9]), "=&v"(tv[10]), "=&v"(tv[11]), "=&v"(tv[12]), "=&v"(tv[13]), "=&v"(tv[14]), "=&v"(tv[15]) : "v"(vaddr) : "memory");
        asm volatile("ds_read_b64_tr_b16 %0, %8 offset:24576\n\t" "ds_read_b64_tr_b16 %1, %8 offset:25344\n\t" "ds_read_b64_tr_b16 %2, %8 offset:27648\n\t" "ds_read_b64_tr_b16 %3, %8 offset:28416\n\t" "ds_read_b64_tr_b16 %4, %8 offset:30720\n\t" "ds_read_b64_tr_b16 %5, %8 offset:31488\n\t" "ds_read_b64_tr_b16 %6, %8 offset:33792\n\t" "ds_read_b64_tr_b16 %7, %8 offset:34560\n\t" "s_waitcnt lgkmcnt(0)" : "=&v"(tv[16]), "=&v"(tv[17]), "=&v"(tv[18]), "=&v"(tv[19]), "=&v"(tv[20]), "=&v"(tv[21]), "=&v"(tv[22]), "=&v"(tv[23]) : "v"(vaddr) : "memory");
#pragma unroll
        for (int ks = 0; ks < 12; ++ks) { const v4u bw = {tv[2 * ks].x, tv[2 * ks].y, tv[2 * ks + 1].x, tv[2 * ks + 1].y};
            o = __builtin_amdgcn_mfma_f32_32x32x16_bf16(*(const LAS bf16x8*)(pa + ks * 16), __builtin_bit_cast(bf16x8, bw), o, 0, 0, 0); }
        bf16* mix = (bf16*)(F.ws + WS_MIX);
#pragma unroll
        for (int i = 0; i < 16; ++i) {
            const int q = acc_row(i, hq);
            const float m0 = Ms[(rt * 2 + 0) * 32 + q], m1 = Ms[(rt * 2 + 1) * 32 + q], mm = fmaxf(fmaxf(m0, m1), sink);
            const float den = (Ss[(rt * 2 + 0) * 32 + q] + Ss[(rt * 2 + 1) * 32 + q]) + __expf(sink - mm);
            mix[(size_t)(seqrow0 + t0 + qhalf * 32 + q) * D + 256 + head * 64 + kh * 32 + r] = f2bf_s(o[i] * rcpf_(den));
        }
    }
    if (t0 == SEQ - 64) {
        for (int e = tid; e < 128 * 16; e += 512) { const int wv = e >> 4, sg = e & 15;
            const bf16* p = proj + (size_t)(seqrow0 + SEQ - 128 + wv) * NPROJ + kvh * 64 + sg * 4;
            const size_t o = ((((size_t)l * NB + b) * 128 + wv) * 2 + kvh) * 64 + sg * 4;
            const v2u ku = *(const v2u*)(p + 1024), vu = *(const v2u*)(p + 1152);
            *(f32x4*)(F.out + O_PK + o) = (f32x4){bflo(ku.x), bfhi(ku.x), bflo(ku.y), bfhi(ku.y)};
            *(f32x4*)(F.out + O_PV + o) = (f32x4){bflo(vu.x), bfhi(vu.x), bflo(vu.y), bfhi(vu.y)}; }
    }
    __syncthreads();
}

__device__ __forceinline__ void scan_phase(Frame& F, int l) {
    const int e = F.vcu * 512 + F.tid;
    if (F.G * 512 >= 131072) {
        const int pe = e & 65535, bh = pe >> 11, el = (pe & 2047) * 2;
        if (e < 65536) {
            unsigned* sl = (unsigned*)((bf16*)(F.ws + WS_SSDLOC) + (size_t)bh * NCH * 4096 + el); const float* dc = (const float*)(F.ws + WS_SMALL) + bh * NCH;
            unsigned v[NCH];
#pragma unroll
            for (int c = 0; c < NCH; ++c) v[c] = __builtin_nontemporal_load(sl + (size_t)c * 2048);
            float r0 = 0.f, r1 = 0.f;
#pragma unroll
            for (int c = 0; c < NCH; ++c) { __builtin_nontemporal_store(pk2(r0, r1), sl + (size_t)c * 2048); const float d = dc[c]; r0 = r0 * d + bflo(v[c]); r1 = r1 * d + bfhi(v[c]); }
            float* o = F.out + O_PSSM + ((size_t)l * 32 + bh) * 4096 + el; o[0] = r0; o[1] = r1;
        } else {
            unsigned* sl = (unsigned*)((bf16*)(F.ws + WS_HGLOC) + (size_t)bh * NCH * 4096 + el); const float* dc = (const float*)(F.ws + WS_SMALL) + 1024 + (size_t)bh * NCH * 64 + (el & 63);
            unsigned v[NCH];
#pragma unroll
            for (int c = 0; c < NCH; ++c) v[c] = __builtin_nontemporal_load(sl + (size_t)c * 2048);
            float r0 = 0.f, r1 = 0.f;
#pragma unroll
            for (int c = 0; c < NCH; ++c) { __builtin_nontemporal_store(pk2(r0, r1), sl + (size_t)c * 2048); r0 = r0 * dc[c * 64] + bflo(v[c]); r1 = r1 * dc[c * 64 + 1] + bfhi(v[c]); }
            float* o = F.out + O_PHG + ((size_t)l * 32 + bh) * 4096 + (el & 63) * 64 + (el >> 6); o[0] = r0; o[64] = r1;
        }
        if (e < NB * 256) {
            const int b = e >> 8, ch = e & 255;
            float* hl = (float*)(F.ws + WS_SMALL) + 1024 + 65536 + (size_t)b * NCH * 256 + ch; const float* al = hl + 65536;
            float run = 0.f, vv[NCH], aa[NCH];
#pragma unroll
            for (int c = 0; c < NCH; ++c) { vv[c] = hl[c * 256]; aa[c] = al[c * 256]; }
#pragma unroll
            for (int c = 0; c < NCH; ++c) { hl[c * 256] = run; run = run * aa[c] + vv[c]; }
            F.out[O_PLRU + ((size_t)l * NB + b) * 256 + ch] = run;
        }
    }
}
constexpr int M1_SSD = 0, M1_SSSD = 256, M1_SHG = 320, M1_SLRU = 384, M1_SSWA = 448, M1_END = 704;
constexpr int M2_SSD = 0, M2_SWA = 256, M2_END = 768;
__device__ __forceinline__ int queue_next(Frame& F, int q) {
    const unsigned shard = blockIdx.x & 7u;
    __syncthreads();
    if (F.tid == 0) F.MISC[16] = __hip_atomic_fetch_add((unsigned*)(F.ctl + CW_QUEUE + 64 * (q * 8 + shard)), 1u, __ATOMIC_RELAXED, __HIP_MEMORY_SCOPE_AGENT) * 8u + shard;
    __syncthreads();
    return (int)F.MISC[16];
}
__device__ __forceinline__ void mixer_phase1(Frame& F0, int l, int qofs = 0) {
    for (;;) {
        int it = queue_next(F0, 2 * l + qofs);
#if defined(PROBE_M1Q)
        if (it >= M1_END + 2048) break;
        if (it >= M1_END) continue;
#elif defined(PROBE_M1S)
        if (it >= M1_END + 448) break;
        if (it >= M1_END) it -= 448;
#elif defined(PROBE_M1P)
        if (it >= M1_END + 256) break;
        if (it >= M1_END) it -= M1_END;
#else
        if (it >= M1_END) break;
#endif
#ifdef PROBE_M1T
        if (qofs && !(it >= PROBE_LO && it < PROBE_HI)) continue;
#endif
        Frame F = F0; OPAQUE_TID(F);
        if (it < M1_SSSD) {
            unsigned short frw[32], vrw[32]; v4u rawr[5];
            ssd_mfma_p1(F, l, it, frw, vrw);
            lru_raw_load(F, it, rawr);
            hgrn_mfma_p1(F, l, it, frw, vrw);
            lru_mfma<false, true>(F, l, it, &rawr);
        }
        else if (it < M1_SHG) ssd_item(F, l, 2, it - M1_SSSD);
        else if (it < M1_SLRU) hgrn_item(F, l, 2, (it - M1_SHG) * 8 + F.wave);
        else if (it < M1_SSWA) lru_item(F, l, 2, (it - M1_SLRU) * 8 + F.wave);
        else swa_item<true>(F, l, it - M1_SSWA);
    }
}
constexpr int CW_GRP = 32768;
__device__ __forceinline__ void group_barrier(Frame& F) {
    asm volatile("s_waitcnt vmcnt(0)" ::: "memory");
    __syncthreads();
    if (threadIdx.x == 0) {
        unsigned* cnt = (unsigned*)(F.ctl + CW_GRP + 64 * (blockIdx.x & 7u)); unsigned* tmo = (unsigned*)(F.ctl + CW_BAR) + XB_TMO;
        const unsigned n = (gridDim.x - (blockIdx.x & 7u) + 7u) / 8u, gen = F.MISC[10], target = (gen + 1u) * n;
#ifndef PROBE_NOREL
        __builtin_amdgcn_fence(__ATOMIC_RELEASE, "agent");
        asm volatile("s_waitcnt vmcnt(0)" ::: "memory");
#endif
        (void)xb_add(cnt, 1u);
        XB_SPIN((int)(xb_ld(cnt) - target) < 0, tmo - XB_TMO);
#ifndef PROBE_NOACQ
        __builtin_amdgcn_fence(__ATOMIC_ACQUIRE, "agent");
        asm volatile("s_waitcnt vmcnt(0)" ::: "memory");
#endif
        F.MISC[10] = gen + 1u;
    }
    __syncthreads();
}
constexpr int CW_CHAIN = 24576;
__device__ __forceinline__ void chain_publish(Frame& F, gu32* cnt) {
    asm volatile("s_waitcnt vmcnt(0)" ::: "memory");
    __syncthreads();
    if (F.tid == 0) {
        __builtin_amdgcn_fence(__ATOMIC_RELEASE, "agent");
        asm volatile("s_waitcnt vmcnt(0)" ::: "memory");
        __hip_atomic_fetch_add((unsigned*)cnt, 1u, __ATOMIC_RELAXED, __HIP_MEMORY_SCOPE_AGENT);
    }
}
__device__ __forceinline__ void chain_wait(Frame& F, gu32* cnt, unsigned target) {
    if (F.tid == 0) {
        unsigned sp = 0;
        while (__hip_atomic_load((unsigned*)cnt, __ATOMIC_RELAXED, __HIP_MEMORY_SCOPE_AGENT) < target) { __builtin_amdgcn_s_sleep(2); if (++sp > (1u << 22)) break; }
        __builtin_amdgcn_fence(__ATOMIC_ACQUIRE, "agent");
        asm volatile("s_waitcnt vmcnt(0)" ::: "memory");
    }
    __syncthreads();
}
constexpr int C_G2S = 16, C_G3S = 64, C_POS3 = C_G2S + 256, M2_QEND = M2_END + C_G2S + C_G3S;
template <int l> __device__ __forceinline__ void mixer_phase2(Frame& F0, int qofs = 0) {
    for (;;) {
        int it = queue_next(F0, 2 * l + 1 + qofs);
        if (it >= M2_QEND) break;
        Frame F = F0; OPAQUE_TID(F);
        if (qofs && (it < C_G2S || (it >= C_POS3 && it < C_POS3 + C_G3S))) continue;
        if (it < C_G2S) {
            pg8::Gemm g{(const bf16*)(F.ws + WS_MIX), (const bf16*)(F.ws + WS_WOUT) + (size_t)l * D * D, M, D, D, 0, 0}; pg8::OneUnit S{MP / 256 + (it >> 2), it & 3, 0};
            pg8::EpiResidualB E{(bf16*)(F.ws + WS_XB), (float*)(F.ws + WS_SSQB)};
            pg8::gemm_phase<pg8::EpiResidualB, pg8::OneUnit, true, true>(F.lds, g, S, E);
            chain_publish(F, F.ctl + CW_CHAIN + 64 * (l * 4 + (it >> 2)));
            continue;
        }
        if (it >= C_POS3 && it < C_POS3 + C_G3S) {
            const int j = it - C_POS3, pnl = j >> 4;
            chain_wait(F, F.ctl + CW_CHAIN + 64 * (l * 4 + pnl), 4u);
            pg8::Gemm g{(const bf16*)(F.ws + WS_XB), (const bf16*)(F.ws + WS_WUP) + (size_t)l * FF * D, M, FF, D, 0, 0}; pg8::OneUnit S{MP / 256 + pnl, j & 15, 0};
            pg8::EpiScaleBf16<1> E{(bf16*)(F.ws + WS_UP), FF, (const float*)(F.ws + WS_SSQB), (unsigned)((size_t)M * FF * 2)};
            pg8::gemm_phase<pg8::EpiScaleBf16<1>, pg8::OneUnit, true, true>(F.lds, g, S, E);
            continue;
        }
        it -= (it < C_POS3) ? C_G2S : C_G2S + C_G3S;
        if (it < M2_SWA) {
            HgPre hp0;
            ssd_mfma_p2<true>(F, l, it, &hp0);
            { LruP2 LP; hgrn_mfma_p2<true>(F, l, it, &hp0, &LP); lru_p2_finish(F, it, LP); }
        }
        else { const int j = it - M2_SWA; swa_mfma(F, l, (j & 7) * 64 + (j >> 3)); }
    }
}

struct Args { const float* in[33]; float* out; unsigned char* ws; int ph_lo, ph_hi, li, pad; };
constexpr int N_PHASES = 1 + 2 * 8;
template <int KIND, int l> __device__ __forceinline__ void layer_phases(Frame& F, const XcdBarrier& bar, int lo, int hi) {
#define KON(k) (KIND == 0 || KIND == (k))
#define IN(k) (lo <= (k) && (k) < hi)
#define SEAM(k) do { if (IN(k) && IN((k) + 1)) xcd_barrier(bar); } while (0)
#define PHASE_FRAME() Frame Fm = F; OPAQUE_TID(Fm);
#define WSP(T, off) ((T*)(F.ws + (off)))
        const int pb = 1 + 8 * l;
        if constexpr (KON(2)) if (IN(pb)) {
            pg8::Gemm g{WSP(bf16, WS_XB), WSP(bf16, WS_WIN) + (size_t)l * NPROJ * D, M, NPROJ, D}; pg8::StaticOrder S; S.init(M, NPROJ, F.G, (int)blockIdx.x);
            pg8::EpiScaleBf16<0> E{WSP(bf16, WS_PROJ), NPROJ, WSP(float, WS_SSQA), (unsigned)((size_t)M * NPROJ * 2)};
            pg8::gemm_phase<pg8::EpiScaleBf16<0>, pg8::StaticOrder, true, true>(F.lds, g, S, E);
#ifdef DBL_G1
            xcd_barrier(bar); pg8::gemm_phase<pg8::EpiScaleBf16<0>, pg8::StaticOrder, true, true>(F.lds, g, S, E);
#endif
        }
        SEAM(pb);
#ifndef SKIP_M1
        if constexpr (KON(3)) if (IN(pb + 1)) { PHASE_FRAME(); mixer_phase1(Fm, l);
#ifdef DBL_M1
            xcd_barrier(bar); mixer_phase1(Fm, l, 8);
#endif
        }
#endif
        SEAM(pb + 1);
#ifndef SKIP_M2
        if constexpr (KON(9)) if (IN(pb + 2)) { PHASE_FRAME(); scan_phase(Fm, l); }
        SEAM(pb + 2);
        if constexpr (KON(4)) if (IN(pb + 3)) { PHASE_FRAME(); mixer_phase2<l>(Fm);
#ifdef DBL_M2
            xcd_barrier(bar); mixer_phase2<l>(Fm, 8);
#endif
        }
#endif
        SEAM(pb + 3);
        if constexpr (KON(5)) if (IN(pb + 4)) {
            pg8::Gemm g{WSP(bf16, WS_MIX), WSP(bf16, WS_WOUT) + (size_t)l * D * D, MP, D, D}; pg8::StaticOrder S; S.init(MP, D, F.G, (int)blockIdx.x);
            pg8::EpiResidualB E{WSP(bf16, WS_XB), WSP(float, WS_SSQB)};
            pg8::gemm_phase<pg8::EpiResidualB, pg8::StaticOrder, true, true>(F.lds, g, S, E);
        }
        SEAM(pb + 4);
        if constexpr (KON(6)) if (IN(pb + 5)) {
            pg8::Gemm g{WSP(bf16, WS_XB), WSP(bf16, WS_WUP) + (size_t)l * FF * D, MP, FF, D}; pg8::StaticOrder S; S.init(MP, FF, F.G, (int)blockIdx.x);
            pg8::EpiScaleBf16<1> E{WSP(bf16, WS_UP), FF, WSP(float, WS_SSQB), (unsigned)((size_t)M * FF * 2)};
            pg8::gemm_phase<pg8::EpiScaleBf16<1>, pg8::StaticOrder, true, true>(F.lds, g, S, E);
#ifdef DBL_G3
            xcd_barrier(bar); pg8::gemm_phase<pg8::EpiScaleBf16<1>, pg8::StaticOrder, true, true>(F.lds, g, S, E);
#endif
#ifdef PROBE_BAR
#pragma unroll 1
            for (int pbi = 0; pbi < 16; ++pbi) xcd_barrier(bar);
#endif
        }
        SEAM(pb + 5);
        if constexpr (KON(7)) if (IN(pb + 6)) {
            { pg8::Gemm g{WSP(bf16, WS_UP), WSP(bf16, WS_WDN) + (size_t)l * D * FF, M, D, FF / G4_KP, FF, (FF / G4_KP) * 2}; pg8::SplitOrder S{F.G, (int)blockIdx.x, MP / 256, G4_KP};
              pg8::EpiPartial E{WSP(bf16, WS_MIX), MP / 256, G4_KP};
              pg8::gemm_phase<pg8::EpiPartial, pg8::SplitOrder, true, true>(F.lds, g, S, E); }
            { pg8::Gemm g{WSP(bf16, WS_UP), WSP(bf16, WS_WDN) + (size_t)l * D * FF, MP, D, FF, 0, 0}; pg8::StaticOrder S; S.init(MP, D, F.G, (int)blockIdx.x);
              pg8::EpiResidualB E{WSP(bf16, WS_XB), WSP(float, WS_SSQA)};
              pg8::gemm_phase<pg8::EpiResidualB, pg8::StaticOrder, true, true>(F.lds, g, S, E); }
        }
        SEAM(pb + 6);
        if constexpr (KON(10)) if (IN(pb + 7)) { PHASE_FRAME(); sample_reduce<l == 1>(Fm); if (l == 1) final_norm(Fm); else dt_pass(Fm, 1, MP); }
        SEAM(pb + 7);
#undef KON
#undef IN
#undef SEAM
#undef PHASE_FRAME
#undef WSP
}
template <int KIND> __global__ void __launch_bounds__(NWAVES * 64, 2) mk_fwd(Args args) {
#define KON(k) (KIND == 0 || KIND == (k))
    extern __shared__ __attribute__((aligned(16))) unsigned char lds[];
    Frame F;
    F.lds = (LAS unsigned char*)lds;
    F.MISC = (volatile LAS unsigned*)(F.lds + MISC_OFF);
    F.tid = threadIdx.x; F.lane = F.tid & 63; F.wave = __builtin_amdgcn_readfirstlane(F.tid >> 6);
    F.G = gridDim.x; { const int bx = blockIdx.x; F.vcu = (F.G % 8 == 0) ? (bx % 8) * (F.G / 8) + bx / 8 : bx; }
    F.out = args.out; F.ws = args.ws; F.ctl = (gu32*)(args.ws + WS_CTL);
    for (int u = F.tid; u < (LDS_BYTES - LDSCTL_OFF) / 4; u += NWAVES * 64) ((LAS unsigned*)(F.lds + LDSCTL_OFF))[u] = 0u;
    __syncthreads();
    if (F.tid == 0) {
#pragma unroll
        for (int i = 0; i < 33; ++i) *(LAS unsigned long long*)(F.lds + PTAB_OFF + 8 * i) = (unsigned long long)args.in[i];
    }
    __syncthreads();
    XcdBarrier bar; bar.bar = (unsigned*)(F.ctl + CW_BAR); bar.x = 0; bar.st = nullptr;
    bar = xcd_barrier_post((unsigned*)(F.ctl + CW_BAR), F.MISC + 8);
    const int lo = args.ph_lo, hi = args.ph_hi;
#define IN(k) (lo <= (k) && (k) < hi)
#define SEAM(k) do { if (IN(k) && IN((k) + 1)) xcd_barrier(bar); } while (0)
#define PHASE_FRAME() Frame Fm = F; OPAQUE_TID(Fm);
#define WSP(T, off) ((T*)(F.ws + (off)))
    if constexpr (KON(1)) if (IN(0)) { PHASE_FRAME(); p0_prologue(Fm);
#ifdef DBL_P0
        xcd_barrier(bar); p0_prologue(Fm);
#endif
    }
    SEAM(0);

    layer_phases<KIND, 0>(F, bar, lo, hi);
    layer_phases<KIND, 1>(F, bar, lo, hi);
#undef IN
#undef SEAM
}

template <int KIND> static void launch_kind(const Args& a, int grid, hipStream_t stream) {
    static bool attr_set = false;
    if (!attr_set) { (void)hipFuncSetAttribute((const void*)mk_fwd<KIND>, hipFuncAttributeMaxDynamicSharedMemorySize, LDS_BYTES); attr_set = true; }
    hipLaunchKernelGGL(mk_fwd<KIND>, dim3(grid), dim3(NWAVES * 64), LDS_BYTES, stream, a);
}
extern "C" void kernel_launch(void* const* d_in, const int* in_sizes, int n_in, void* d_out, int out_size, void* d_ws, size_t ws_size, hipStream_t stream) {
    static int grid = 0;
    if (grid == 0) {
        if (n_in != 33 || out_size != (int)O_END || ws_size < WS_END) { fprintf(stderr, "kernel_launch: unexpected shapes n_in %d out %d ws %zu\n", n_in, out_size, ws_size); grid = -1; return; }
        int dev = 0, cus = 0;
        if (hipGetDevice(&dev) != hipSuccess || hipDeviceGetAttribute(&cus, hipDeviceAttributeMultiprocessorCount, dev) != hipSuccess) { grid = -1; return; }
        grid = cus;
    }
    if (grid < 0) return;
    (void)hipMemsetAsync((char*)d_ws + WS_CTL, 0, CTL_ZERO_BYTES, stream);
    Args a{};
    for (int i = 0; i < 33; ++i) a.in[i] = (const float*)d_in[i];
    a.out = (float*)d_out; a.ws = (unsigned char*)d_ws;
    a.ph_lo = 0; a.ph_hi = N_PHASES; a.li = 0;
    launch_kind<0>(a, grid, stream);
}
```
